# Optimizing an MI355X kernel written in HIP

```python
import jax
import jax.numpy as jnp
from jax import lax
import numpy as np

D_MODEL = 1024
BATCH = 8
SEQ = 2048
DEPTH = 2

GRID_W = 64
CTX_LEN = 256
EPS = 1e-6
NEG_INF = -1e30
HEAD_DIM = 64

POOL_WIDTH = D_MODEL // 4
POOL_WINDOWS = (2, 4, 8, 16)
POOL_GROUP = POOL_WIDTH // len(POOL_WINDOWS)

GDN_WIDTH = (3 * D_MODEL) // 8
GDN_HEADS = GDN_WIDTH // HEAD_DIM
GDN_CHUNK = 64
CONV_K = 5

ATTN_WIDTH = D_MODEL - POOL_WIDTH - GDN_WIDTH
ATTN_HEADS = ATTN_WIDTH // HEAD_DIM
KV_HEADS = 2
ATTN_GROUP = ATTN_HEADS // KV_HEADS
KV_WIDTH = KV_HEADS * HEAD_DIM
WINDOW = 128
ATTN_BLOCK = 128
ROPE_BASE = 10000.0
ROPE_PAIRS = HEAD_DIM // 4

IN_SPLITS = (POOL_WIDTH, 3 * GDN_WIDTH, GDN_WIDTH, 4 * GDN_HEADS, ATTN_WIDTH, KV_WIDTH, KV_WIDTH)
IN_WIDTH = POOL_WIDTH + 4 * GDN_WIDTH + 4 * GDN_HEADS + ATTN_WIDTH + 2 * KV_WIDTH

PEER_HEADS = 8
N_KEYS = 128
N_EXPERTS = N_KEYS * N_KEYS
PEER_TOPK = 16
PEER_QDIM = 256
PEER_HALF = PEER_QDIM // 2
PEER_BLOCK = 128

kernel_name = "hybrid_pool_gdn_swa_peer_dit"


def rmsnorm(x, gain):
    xf = x.astype(jnp.float32)
    y = xf * lax.rsqrt(jnp.mean(jnp.square(xf), axis=-1, keepdims=True) + EPS)
    return (y * gain.astype(jnp.float32)).astype(x.dtype)


def l2norm(x):
    return x * lax.rsqrt(jnp.sum(jnp.square(x), axis=-1, keepdims=True) + EPS)


def split_cols(p):
    idx, acc = [], 0
    for w in IN_SPLITS[:-1]:
        acc += w
        idx.append(acc)
    return jnp.split(p, idx, axis=-1)


def axial_rope_tables(seq_len):
    rows = seq_len // GRID_W
    r, col = jnp.meshgrid(jnp.arange(rows), jnp.arange(GRID_W), indexing='ij')
    pos = jnp.stack([r.reshape(-1), col.reshape(-1)], axis=-1).astype(jnp.float32)
    inv = jnp.power(ROPE_BASE, -jnp.arange(ROPE_PAIRS, dtype=jnp.float32) / ROPE_PAIRS)
    ang = pos[:, :, None] * inv
    return jnp.cos(ang), jnp.sin(ang)


def apply_rope(x, tables):
    cos, sin = tables
    xf = x.astype(jnp.float32).reshape(x.shape[:-1] + (2, 2, ROPE_PAIRS))
    x1, x2 = xf[..., 0, :], xf[..., 1, :]
    c, s = cos[:, None], sin[:, None]
    out = jnp.stack([x1 * c - x2 * s, x2 * c + x1 * s], axis=-2)
    return out.reshape(x.shape).astype(x.dtype)


def multiscale_pool(a, w_pool, pool_scale):
    L = a.shape[1]
    af = a.astype(jnp.float32)
    cs = jnp.pad(jnp.cumsum(af, axis=1), ((0, 0), (1, 0), (0, 0)))
    t = jnp.arange(L)
    outs = []
    for gi, w in enumerate(POOL_WINDOWS):
        ch = slice(gi * POOL_GROUP, (gi + 1) * POOL_GROUP)
        lo = jnp.clip(t - w // 2, 0, L)
        hi = jnp.clip(t + w - w // 2, 0, L)
        csg = cs[..., ch]
        win_sum = jnp.take(csg, hi, axis=1) - jnp.take(csg, lo, axis=1)
        cnt = (hi - lo).astype(jnp.float32)[None, :, None]
        pooled = win_sum / cnt - af[..., ch]
        outs.append(jnp.einsum('blc,ce->ble', pooled, w_pool[gi].astype(jnp.float32)))
    return (jnp.concatenate(outs, axis=-1) * pool_scale.astype(jnp.float32)).astype(a.dtype)


def short_conv(u, w):
    ch = u.shape[-1]
    y = lax.conv_general_dilated(u, w[:, None, :].astype(u.dtype), window_strides=(1,),
                                 padding=[(CONV_K // 2, CONV_K // 2)],
                                 dimension_numbers=('NWC', 'WIO', 'NWC'), feature_group_count=ch)
    return jax.nn.silu(y)


def gated_delta_chunked(q, k, v, g, beta, state0):
    bn, nh, L, dk = k.shape
    dv = v.shape[-1]
    n = L // GDN_CHUNK
    q = q * (dk ** -0.5)
    rs = lambda t: t.reshape(bn, nh, n, GDN_CHUNK, t.shape[-1])
    qc, kc, vc = rs(q), rs(k), rs(v)
    bc = beta.reshape(bn, nh, n, GDN_CHUNK)
    gc = jnp.cumsum(g.reshape(bn, nh, n, GDN_CHUNK), axis=-1)
    tri = jnp.tril(jnp.ones((GDN_CHUNK, GDN_CHUNK), dtype=bool))
    strict = jnp.tril(jnp.ones((GDN_CHUNK, GDN_CHUNK), dtype=bool), -1)
    diff = gc[..., :, None] - gc[..., None, :]
    decay = jnp.where(tri, jnp.exp(jnp.where(tri, diff, 0.0)), 0.0)
    kb = kc * bc[..., None]
    lower = jnp.where(strict, jnp.einsum('bhnid,bhnjd->bhnij', kb, kc) * decay, 0.0)
    a_mat = lower + jnp.eye(GDN_CHUNK, dtype=jnp.float32)
    rhs = jnp.concatenate([vc * bc[..., None], kb * jnp.exp(gc)[..., None]], axis=-1)
    sol = lax.linalg.triangular_solve(a_mat, rhs, left_side=True, lower=True, unit_diagonal=True)
    u_c, w_c = sol[..., :dv], sol[..., dv:]
    attn_local = jnp.einsum('bhnid,bhnjd->bhnij', qc, kc) * decay
    q_dec = qc * jnp.exp(gc)[..., None]
    k_dec = kc * jnp.exp(gc[..., -1:] - gc)[..., None]
    g_last = jnp.exp(gc[..., -1])

    def step(state, xs):
        u, w, qd, kd, al, gl = xs
        v_new = u - jnp.einsum('bhcd,bhde->bhce', w, state)
        o = jnp.einsum('bhcd,bhde->bhce', qd, state) + jnp.einsum('bhij,bhje->bhie', al, v_new)
        state = state * gl[..., None, None] + jnp.einsum('bhcd,bhce->bhde', kd, v_new)
        return state, o

    xs = tuple(jnp.moveaxis(t, 2, 0) for t in (u_c, w_c, q_dec, k_dec, attn_local, g_last))
    state, o = lax.scan(step, state0, xs)
    o = jnp.moveaxis(o, 0, 2).reshape(bn, nh, L, dv)
    return o, state


def gated_deltanet(qkv_x, z_x, ba_x, qkv_c, z_c, ba_c, conv_w, a_log, dt_bias, out_gain, need_ctx):
    def prep(qkv, ba):
        bn, L, _ = qkv.shape
        y = short_conv(qkv, conv_w).astype(jnp.float32)
        heads = lambda t: t.reshape(bn, L, GDN_HEADS, HEAD_DIM).transpose(0, 2, 1, 3)
        q, k, v = [heads(t) for t in jnp.split(y, 3, axis=-1)]
        ba = ba.astype(jnp.float32).reshape(bn, L, 4, GDN_HEADS).transpose(2, 0, 3, 1)
        beta = jax.nn.sigmoid(ba[:2])
        g = -jnp.exp(a_log.astype(jnp.float32))[:, None, :, None] * jax.nn.softplus(
            ba[2:] + dt_bias.astype(jnp.float32)[:, None, :, None])
        return l2norm(q), l2norm(k), v, beta, g

    def finish(o, z):
        bn, nh, L, d = o.shape
        o = o.transpose(0, 2, 1, 3)
        o = o * lax.rsqrt(jnp.mean(jnp.square(o), axis=-1, keepdims=True) + EPS) * out_gain.astype(jnp.float32)
        return (o.reshape(bn, L, GDN_WIDTH) * jax.nn.silu(z.astype(jnp.float32))).astype(z.dtype)

    qx, kx, vx, beta_x, g_x = prep(qkv_x, ba_x)
    qc, kc, vc, beta_c, g_c = prep(qkv_c, ba_c)
    bn = qx.shape[0]
    outs_x, outs_c = [], []
    for d in range(2):
        fl = (lambda t: jnp.flip(t, axis=2)) if d == 1 else (lambda t: t)
        s0 = jnp.zeros((bn, GDN_HEADS, HEAD_DIM, HEAD_DIM), jnp.float32)
        oc_d, s_ctx = gated_delta_chunked(fl(qc), fl(kc), fl(vc), fl(g_c[d]), fl(beta_c[d]), s0)
        ox_d, _ = gated_delta_chunked(fl(qx), fl(kx), fl(vx), fl(g_x[d]), fl(beta_x[d]), s_ctx)
        outs_x.append(fl(ox_d))
        outs_c.append(fl(oc_d))
    y_x = finish(outs_x[0] + outs_x[1], z_x)
    y_c = finish(outs_c[0] + outs_c[1], z_c) if need_ctx else None
    return y_x, y_c


def window_attention(q_x, k_x, v_x, q_c, k_c, v_c, sink, rope, need_ctx):
    bn, S, _ = q_x.shape
    lc = q_c.shape[1]
    nb = S // ATTN_BLOCK
    nk = 3 * ATTN_BLOCK
    scale = HEAD_DIM ** -0.5
    qx = apply_rope(q_x.reshape(bn, S, ATTN_HEADS, HEAD_DIM), rope)
    kx = apply_rope(k_x.reshape(bn, S, KV_HEADS, HEAD_DIM), rope)
    vx = v_x.reshape(bn, S, KV_HEADS, HEAD_DIM)
    kc = k_c.reshape(bn, lc, KV_HEADS, HEAD_DIM)
    vc = v_c.reshape(bn, lc, KV_HEADS, HEAD_DIM)
    qb = qx.reshape(bn, nb, ATTN_BLOCK, KV_HEADS, ATTN_GROUP, HEAD_DIM)

    def band(t):
        tp = jnp.pad(t, ((0, 0), (ATTN_BLOCK, ATTN_BLOCK), (0, 0), (0, 0)))
        tp = tp.reshape(bn, nb + 2, ATTN_BLOCK, KV_HEADS, HEAD_DIM)
        return jnp.concatenate([tp[:, :-2], tp[:, 1:-1], tp[:, 2:]], axis=2)

    kb, vb = band(kx), band(vx)
    qo = jnp.arange(ATTN_BLOCK)[:, None]
    ko = jnp.arange(nk)[None, :]
    kpos = jnp.arange(nb)[:, None, None] * ATTN_BLOCK - ATTN_BLOCK + ko[None]
    mask = (jnp.abs(ko - ATTN_BLOCK - qo) <= WINDOW)[None] & (kpos >= 0) & (kpos < S)
    s_loc = jnp.einsum('bnqhgd,bnkhd->bnhgqk', qb, kb).astype(jnp.float32) * scale
    s_loc = jnp.where(mask[None, :, None, None], s_loc, NEG_INF)
    s_ctx = jnp.einsum('bnqhgd,bkhd->bnhgqk', qb, kc).astype(jnp.float32) * scale
    sink_h = sink.astype(jnp.float32).reshape(KV_HEADS, ATTN_GROUP, 1, 1)
    sink_l = jnp.broadcast_to(sink_h, s_loc.shape[:-1] + (1,))
    p = jax.nn.softmax(jnp.concatenate([s_loc, s_ctx, sink_l], axis=-1), axis=-1).astype(vx.dtype)
    o = (jnp.einsum('bnhgqk,bnkhd->bnqhgd', p[..., :nk], vb)
         + jnp.einsum('bnhgqk,bkhd->bnqhgd', p[..., nk:nk + lc], vc))
    y_x = o.reshape(bn, S, ATTN_WIDTH)
    if need_ctx:
        qcc = q_c.reshape(bn, lc, KV_HEADS, ATTN_GROUP, HEAD_DIM)
        s = jnp.einsum('bqhgd,bkhd->bhgqk', qcc, kc).astype(jnp.float32) * scale
        sink_c = jnp.broadcast_to(sink_h, s.shape[:-1] + (1,))
        pc = jax.nn.softmax(jnp.concatenate([s, sink_c], axis=-1), axis=-1).astype(vc.dtype)
        y_c = jnp.einsum('bhgqk,bkhd->bqhgd', pc[..., :lc], vc).reshape(bn, lc, ATTN_WIDTH)
    else:
        y_c = None
    return y_x, y_c


def token_mixing(hx, hc, w_in, conv_w, a_log, dt_bias, gdn_norm, w_pool, pool_scale, sink, w_out, rope, need_ctx):
    ax, qkvx, zx, bax, qx, kx, vx = split_cols(hx @ w_in)
    ac, qkvc, zc, bac, qc, kc, vc = split_cols(hc @ w_in)
    ya_x = multiscale_pool(ax, w_pool, pool_scale)
    yb_x, yb_c = gated_deltanet(qkvx, zx, bax, qkvc, zc, bac, conv_w, a_log, dt_bias, gdn_norm, need_ctx)
    yc_x, yc_c = window_attention(qx, kx, vx, qc, kc, vc, sink, rope, need_ctx)
    out_x = jnp.concatenate([ya_x, yb_x, yc_x], axis=-1) @ w_out
    if need_ctx:
        ya_c = multiscale_pool(ac, w_pool, pool_scale)
        out_c = jnp.concatenate([ya_c, yb_c, yc_c], axis=-1) @ w_out
    else:
        out_c = None
    return out_x, out_c


def peer_ffn(h, w_query, sub_keys, u_tab, v_tab):
    bn, L, D = h.shape
    h_blocks = h.reshape(bn * L // PEER_BLOCK, PEER_BLOCK, D)

    def one_block(hb):
        q = (hb @ w_query).reshape(PEER_BLOCK, PEER_HEADS, 2, PEER_HALF)
        s = jnp.einsum('thpd,hpkd->thpk', q, sub_keys).astype(jnp.float32)
        sv, si = lax.top_k(s, PEER_TOPK)
        cand = (sv[:, :, 0, :, None] + sv[:, :, 1, None, :]).reshape(PEER_BLOCK, PEER_HEADS, PEER_TOPK * PEER_TOPK)
        cv, ci = lax.top_k(cand, PEER_TOPK)
        i1 = jnp.take_along_axis(si[:, :, 0], ci // PEER_TOPK, axis=-1)
        i2 = jnp.take_along_axis(si[:, :, 1], ci % PEER_TOPK, axis=-1)
        expert = i1 * N_KEYS + i2
        gate = jax.nn.softmax(cv, axis=-1)
        u = jnp.take(u_tab, expert, axis=0)
        v = jnp.take(v_tab, expert, axis=0)
        act = jax.nn.gelu(jnp.einsum('td,thkd->thk', hb, u).astype(jnp.float32), approximate=False)
        return jnp.einsum('thk,thkd->td', (gate * act).astype(v.dtype), v).astype(h.dtype)

    return lax.map(one_block, h_blocks).reshape(bn, L, D)


def setup_inputs(seed: int = 0) -> dict:
    key = jax.random.key(seed)
    ks = jax.random.split(key, 24)
    f32 = jnp.float32
    nrm = lambda k, shape, s: jax.random.normal(k, shape, f32) * s
    D = D_MODEL
    dt = jnp.exp(jax.random.uniform(ks[11], (DEPTH, 2, GDN_HEADS), f32, np.log(1e-3), np.log(1e-1)))
    return {
        "x": nrm(ks[0], (BATCH, SEQ, D), 1.0),
        "c": nrm(ks[1], (BATCH, D), 1.0),
        "ctx": nrm(ks[2], (BATCH, CTX_LEN, D), 1.0),
        "c_ctx": nrm(ks[3], (D,), 1.0),
        "w_ada": nrm(ks[4], (DEPTH, D, 6 * D), 0.5 * D ** -0.5),
        "b_ada": nrm(ks[5], (DEPTH, 6 * D), 0.02),
        "norm1": 1.0 + nrm(ks[6], (DEPTH, D), 0.02),
        "norm2": 1.0 + nrm(ks[7], (DEPTH, D), 0.02),
        "w_in": nrm(ks[8], (DEPTH, D, IN_WIDTH), D ** -0.5),
        "conv_w": nrm(ks[9], (DEPTH, CONV_K, 3 * GDN_WIDTH), CONV_K ** -0.5),
        "a_log": jnp.log(jax.random.uniform(ks[10], (DEPTH, 2, GDN_HEADS), f32, 1.0, 16.0)),
        "dt_bias": jnp.log(jnp.expm1(dt)),
        "gdn_norm": 1.0 + nrm(ks[12], (DEPTH, HEAD_DIM), 0.02),
        "w_pool": nrm(ks[13], (DEPTH, len(POOL_WINDOWS), POOL_GROUP, POOL_GROUP), POOL_GROUP ** -0.5),
        "pool_scale": 1.0 + nrm(ks[14], (DEPTH, POOL_WIDTH), 0.1),
        "sink": nrm(ks[15], (DEPTH, ATTN_HEADS), 1.0),
        "w_out": nrm(ks[16], (DEPTH, D, D), D ** -0.5),
        "peer_wq": nrm(ks[17], (DEPTH, D, PEER_HEADS * PEER_QDIM), D ** -0.5),
        "peer_keys": nrm(ks[18], (DEPTH, PEER_HEADS, 2, N_KEYS, PEER_HALF), PEER_HALF ** -0.5),
        "peer_u": nrm(ks[19], (DEPTH, N_EXPERTS, D), D ** -0.5),
        "peer_v": nrm(ks[20], (DEPTH, N_EXPERTS, D), 1.0),
        "norm_f": 1.0 + nrm(ks[21], (D,), 0.02),
    }


def reference(x, c, ctx, c_ctx, w_ada, b_ada, norm1, norm2, w_in, conv_w, a_log, dt_bias, gdn_norm,
              w_pool, pool_scale, sink, w_out, peer_wq, peer_keys, peer_u, peer_v, norm_f):
    rope = axial_rope_tables(x.shape[1])
    silu_c = jax.nn.silu(c)
    silu_cc = jax.nn.silu(c_ctx)
    h_ctx = ctx
    for l in range(DEPTH):
        need_ctx = l < DEPTH - 1
        mod_x = (silu_c @ w_ada[l] + b_ada[l])[:, None, :]
        mod_c = silu_cc @ w_ada[l] + b_ada[l]
        sh1, sc1, g1, sh2, sc2, g2 = jnp.split(mod_x, 6, axis=-1)
        csh1, csc1, cg1, csh2, csc2, cg2 = jnp.split(mod_c, 6, axis=-1)
        hx = rmsnorm(x, norm1[l]) * (1.0 + sc1) + sh1
        hc = rmsnorm(h_ctx, norm1[l]) * (1.0 + csc1) + csh1
        out_x, out_c = token_mixing(hx, hc, w_in[l], conv_w[l], a_log[l], dt_bias[l], gdn_norm[l],
                                    w_pool[l], pool_scale[l], sink[l], w_out[l], rope, need_ctx)
        x = x + g1 * out_x
        hx = rmsnorm(x, norm2[l]) * (1.0 + sc2) + sh2
        x = x + g2 * peer_ffn(hx, peer_wq[l], peer_keys[l], peer_u[l], peer_v[l])
        if need_ctx:
            h_ctx = h_ctx + cg1 * out_c
            hc = rmsnorm(h_ctx, norm2[l]) * (1.0 + csc2) + csh2
            h_ctx = h_ctx + cg2 * peer_ffn(hc, peer_wq[l], peer_keys[l], peer_u[l], peer_v[l])
    return rmsnorm(x, norm_f)
```

```cpp
#include <hip/hip_runtime.h>
#include <stdint.h>
#include <stdio.h>

#define DEVI __device__ __forceinline__
typedef unsigned short bf16_t;
typedef __attribute__((ext_vector_type(8))) short bf16x8;
typedef __attribute__((ext_vector_type(4))) float f32x4;
typedef __attribute__((ext_vector_type(4))) unsigned u32x4;

#ifndef N_LAUNCH_MODE
#define N_LAUNCH_MODE 0
#endif

constexpr int D = 1024, NB = 8, SEQ = 2048, LC = 256;
constexpr int NX = NB * SEQ, NC = NB * LC, NTOK = NX + NC;
constexpr int INW = 2456, INWP = 2560;
constexpr int C_POOL = 0, C_GQKV = 256, C_GZ = 1408, C_GBA = 1792, C_AQ = 1816, C_AK = 2200, C_AV = 2328;
constexpr int NEXP = 16384;
constexpr int NT = 256;
constexpr int SMEM_BYTES = 49152;

constexpr size_t al256(size_t x) { return (x + 255) & ~(size_t)255; }
constexpr size_t WS_BAR   = 0;
constexpr size_t WS_MODP  = 16384;
constexpr size_t WS_MOD   = WS_MODP  + al256((size_t)8 * 2 * 9 * 6144 * 4);
constexpr size_t WS_ROPE  = WS_MOD   + al256((size_t)2 * 9 * 6144 * 4);
constexpr size_t WS_WINT  = WS_ROPE  + al256((size_t)2 * 2048 * 32 * 4);
constexpr size_t WS_WOUTT = WS_WINT  + al256((size_t)2 * INWP * 1024 * 2);
constexpr size_t WS_WQT   = WS_WOUTT + al256((size_t)2 * 1024 * 1024 * 2);
constexpr size_t WS_KB    = WS_WQT   + al256((size_t)2 * 2048 * 1024 * 2);
constexpr size_t WS_UB    = WS_KB    + al256((size_t)2 * 8 * 2 * 128 * 128 * 2);
constexpr size_t WS_VB    = WS_UB    + al256((size_t)2 * NEXP * 1024 * 2);
constexpr size_t WS_XC    = WS_VB    + al256((size_t)2 * NEXP * 1024 * 2);
constexpr size_t WS_H     = WS_XC    + al256((size_t)NC * 1024 * 4);
constexpr size_t WS_Y     = WS_H     + al256((size_t)NTOK * 1024 * 2);
constexpr size_t WS_P     = WS_Y     + al256((size_t)NTOK * 1024 * 2);
constexpr size_t WS_GQKV  = WS_P     + al256((size_t)NTOK * INW * 2);
constexpr size_t WS_GG    = WS_GQKV  + al256((size_t)NTOK * 1152 * 4);
constexpr size_t WS_GBETA = WS_GG    + al256((size_t)2 * NTOK * 6 * 4);
constexpr size_t WS_GO    = WS_GBETA + al256((size_t)2 * NTOK * 6 * 4);
constexpr size_t WS_RIDX  = WS_GO    + al256((size_t)2 * NTOK * 384 * 4);
constexpr size_t WS_RGATE = WS_RIDX  + al256((size_t)NTOK * 128 * 4);
constexpr size_t WS_TOTAL = WS_RGATE + al256((size_t)NTOK * 128 * 4);

struct Params {
    const float* in[22];
    float* out;
    unsigned char* ws;
    int pad0, pad1;
};
enum { I_X = 0, I_C, I_CTX, I_CCTX, I_WADA, I_BADA, I_NORM1, I_NORM2, I_WIN, I_CONVW, I_ALOG, I_DTB, I_GDNN, I_WPOOL, I_PSCALE, I_SINK, I_WOUT, I_WQ, I_KEYS, I_PU, I_PV, I_NORMF };

DEVI float bf2f(bf16_t v) { return __uint_as_float(((unsigned)v) << 16); }
DEVI unsigned cvt_pk_bf16(float lo, float hi) { unsigned r; asm volatile("v_cvt_pk_bf16_f32 %0, %1, %2" : "=v"(r) : "v"(lo), "v"(hi)); return r; }
DEVI bf16_t f2bf(float f) { return (bf16_t)(cvt_pk_bf16(f, 0.f) & 0xffffu); }
DEVI float lo_f(unsigned u) { return __uint_as_float(u << 16); }
DEVI float hi_f(unsigned u) { return __uint_as_float(u & 0xffff0000u); }
DEVI float wave_sum(float v) {
#pragma unroll
    for (int m = 32; m >= 1; m >>= 1) v += __shfl_xor(v, m);
    return v;
}
DEVI float wave_max(float v) {
#pragma unroll
    for (int m = 32; m >= 1; m >>= 1) v = fmaxf(v, __shfl_xor(v, m));
    return v;
}
DEVI float silu_f(float x) { return x / (1.f + __expf(-x)); }
DEVI float sigmoid_f(float x) { return 1.f / (1.f + __expf(-x)); }
DEVI float softplus_f(float x) { return fmaxf(x, 0.f) + log1pf(__expf(-fabsf(x))); }
DEVI float gelu_f(float x) { return 0.5f * x * (1.f + erff(x * 0.70710678118654752f)); }

DEVI int row_modrow(int r) { return r < NX ? (r >> 11) : 8; }
DEVI float* xrow_ptr(const Params& p, int r) {
    return r < NX ? p.out + (size_t)r * D : (float*)(p.ws + WS_XC) + (size_t)(r - NX) * D;
}
DEVI const float* mod_ptr(const Params& p, int l, int mrow, int chunk) {
    return (const float*)(p.ws + WS_MOD) + ((size_t)(l * 9 + mrow) * 6 + chunk) * D;
}

#define XB_TMO      128
#define XB_XCNT(j)  (256  + 64 * (j))
#define XB_XSUB(j)  (1280 + 64 * (j))
#define XB_XGEN(j)  (2304 + 64 * (j))
#define XB_TOP      3328
#define XB_TOPGEN   3392
#define XCD_BAR_WORDS 3456
#define XB_SPIN_CAP (1u << 22)
#define LAS __attribute__((address_space(3)))
DEVI unsigned xb_ld(unsigned* p)              { return __hip_atomic_load(p, __ATOMIC_RELAXED, __HIP_MEMORY_SCOPE_AGENT); }
DEVI unsigned xb_add(unsigned* p, unsigned v) { return __hip_atomic_fetch_add(p, v, __ATOMIC_RELAXED, __HIP_MEMORY_SCOPE_AGENT); }
DEVI unsigned xb_xcc_id() { return (unsigned)__builtin_amdgcn_s_getreg((3 << 11) | 20) & 0xFu; }
#define XB_SPIN(cond, bar) do { unsigned _sp = 0; while (cond) { __builtin_amdgcn_s_sleep(1); \
    if ((++_sp & 255u) == 0u) { if (xb_ld(&(bar)[XB_TMO])) break; if (_sp > XB_SPIN_CAP) { atomicAdd(&(bar)[XB_TMO], 1u); break; } } } } while (0)
struct XcdBarrier { unsigned* bar; unsigned x; volatile LAS unsigned* st; };
DEVI XcdBarrier xcd_barrier_post(unsigned* bar, volatile LAS unsigned* st) {
    XcdBarrier b; b.bar = bar; b.x = xb_xcc_id(); b.st = st;
    if (threadIdx.x == 0) (void)xb_add(&bar[XB_XCNT(b.x)], 1u);
    return b;
}
DEVI void xcd_barrier_complete(unsigned* bar, unsigned x, unsigned& nloc, unsigned& nx) {
    const unsigned G = gridDim.x * gridDim.y * gridDim.z;
    unsigned sum, cnt, mine, sp = 0u;
    for (;;) {
        sum = 0u; cnt = 0u; mine = 0u;
#pragma unroll
        for (unsigned j = 0; j < 16; ++j) { const unsigned c = xb_ld(&bar[XB_XCNT(j)]); sum += c; cnt += (c > 0u) ? 1u : 0u; mine = (j == x) ? c : mine; }
        if (sum == G) break;
        __builtin_amdgcn_s_sleep(1);
        if ((++sp & 255u) == 0u) { if (xb_ld(&bar[XB_TMO])) break; if (sp > XB_SPIN_CAP) { atomicAdd(&bar[XB_TMO], 1u); break; } }
    }
    nloc = mine > 0u ? mine : 1u; nx = cnt > 0u ? cnt : 1u;
}
DEVI void xcd_barrier(const XcdBarrier& b) {
    asm volatile("s_waitcnt vmcnt(0)" ::: "memory");
    __syncthreads();
    if (threadIdx.x == 0) {
        unsigned* bar = b.bar;
        __builtin_amdgcn_s_waitcnt(0);
        unsigned nloc = b.st[0], nx = b.st[1];
        if (nloc == 0u) { xcd_barrier_complete(bar, b.x, nloc, nx); b.st[0] = nloc; b.st[1] = nx; }
        const unsigned old = xb_add(&bar[XB_XSUB(b.x)], 1u);
        const unsigned gen = old / nloc;
        if (old + 1u == (gen + 1u) * nloc) {
            __builtin_amdgcn_fence(__ATOMIC_RELEASE, "agent");
            asm volatile("s_waitcnt vmcnt(0)" ::: "memory");
            const unsigned og = xb_add(&bar[XB_TOP], 1u);
            const unsigned tg = og / nx;
            if (og + 1u == (tg + 1u) * nx) xb_add(&bar[XB_TOPGEN], 1u);
            else XB_SPIN(xb_ld(&bar[XB_TOPGEN]) == tg, bar);
            __builtin_amdgcn_fence(__ATOMIC_ACQUIRE, "agent");
            xb_add(&bar[XB_XGEN(b.x)], 1u);
            asm volatile("s_waitcnt vmcnt(0)" ::: "memory");
        } else {
            XB_SPIN(xb_ld(&bar[XB_XGEN(b.x)]) == gen, bar);
            __builtin_amdgcn_fence(__ATOMIC_ACQUIRE, "agent");
            asm volatile("s_waitcnt vmcnt(0)" ::: "memory");
        }
    }
    __syncthreads();
}

DEVI void cvt_bf16_job(const float* __restrict__ src, bf16_t* __restrict__ dst, size_t n) {
    const size_t n8 = n >> 3;
    for (size_t i = (size_t)blockIdx.x * NT + threadIdx.x; i < n8; i += (size_t)gridDim.x * NT) {
        const float4 a = ((const float4*)src)[2 * i], b = ((const float4*)src)[2 * i + 1];
        uint4 o; o.x = cvt_pk_bf16(a.x, a.y); o.y = cvt_pk_bf16(a.z, a.w); o.z = cvt_pk_bf16(b.x, b.y); o.w = cvt_pk_bf16(b.z, b.w);
        ((uint4*)dst)[i] = o;
    }
}
DEVI void copy_job(const float* __restrict__ src, float* __restrict__ dst, size_t n) {
    const size_t n4 = n >> 2;
    for (size_t i = (size_t)blockIdx.x * NT + threadIdx.x; i < n4; i += (size_t)gridDim.x * NT) ((float4*)dst)[i] = ((const float4*)src)[i];
}
DEVI void transpose_tile(const float* __restrict__ src, bf16_t* __restrict__ dst, int Nsrc, int k0, int n0, unsigned char* smem) {
    float* tile = (float*)smem;
    const int tid = threadIdx.x;
    __syncthreads();
#pragma unroll
    for (int it = 0; it < 4; ++it) {
        const int kk = it * 16 + (tid >> 4), nn = (tid & 15) * 4;
#pragma unroll
        for (int j = 0; j < 4; ++j) {
            const int n = n0 + nn + j;
            tile[kk * 65 + nn + j] = (n < Nsrc) ? src[(size_t)(k0 + kk) * Nsrc + n] : 0.f;
        }
    }
    __syncthreads();
#pragma unroll
    for (int it = 0; it < 2; ++it) {
        const int nn = it * 32 + (tid >> 3), kc = (tid & 7) * 8;
        float v[8];
#pragma unroll
        for (int j = 0; j < 8; ++j) v[j] = tile[(kc + j) * 65 + nn];
        uint4 o; o.x = cvt_pk_bf16(v[0], v[1]); o.y = cvt_pk_bf16(v[2], v[3]); o.z = cvt_pk_bf16(v[4], v[5]); o.w = cvt_pk_bf16(v[6], v[7]);
        *(uint4*)(dst + (size_t)(n0 + nn) * 1024 + k0 + kc) = o;
    }
}
DEVI void phase_prep(const Params& p, unsigned char* smem) {
    const int tid = threadIdx.x;
    unsigned char* ws = p.ws;
    copy_job(p.in[I_X], p.out, (size_t)NX * D);
    copy_job(p.in[I_CTX], (float*)(ws + WS_XC), (size_t)NC * D);
    cvt_bf16_job(p.in[I_KEYS], (bf16_t*)(ws + WS_KB), (size_t)2 * 8 * 2 * 128 * 128);
    cvt_bf16_job(p.in[I_PU], (bf16_t*)(ws + WS_UB), (size_t)2 * NEXP * 1024);
    cvt_bf16_job(p.in[I_PV], (bf16_t*)(ws + WS_VB), (size_t)2 * NEXP * 1024);
    {
        const int T_IN = 16 * (INWP / 64), T_OUT = 16 * 16, T_Q = 16 * 32;
        const int total = 2 * (T_IN + T_OUT + T_Q);
        for (int t = blockIdx.x; t < total; t += gridDim.x) {
            int l = t / (T_IN + T_OUT + T_Q), u = t % (T_IN + T_OUT + T_Q);
            if (u < T_IN) {
                const int kt = u / (INWP / 64), nt = u % (INWP / 64);
                transpose_tile(p.in[I_WIN] + (size_t)l * 1024 * INW, (bf16_t*)(ws + WS_WINT) + (size_t)l * INWP * 1024, INW, kt * 64, nt * 64, smem);
            } else if (u < T_IN + T_OUT) {
                u -= T_IN; const int kt = u / 16, nt = u % 16;
                transpose_tile(p.in[I_WOUT] + (size_t)l * 1024 * 1024, (bf16_t*)(ws + WS_WOUTT) + (size_t)l * 1024 * 1024, 1024, kt * 64, nt * 64, smem);
            } else {
                u -= T_IN + T_OUT; const int kt = u / 32, nt = u % 32;
                transpose_tile(p.in[I_WQ] + (size_t)l * 1024 * 2048, (bf16_t*)(ws + WS_WQT) + (size_t)l * 2048 * 1024, 2048, kt * 64, nt * 64, smem);
            }
        }
    }
    {
        float* sc = (float*)smem;
        float* modp = (float*)(ws + WS_MODP);
        for (int t = blockIdx.x; t < 2 * 8 * 24; t += gridDim.x) {
            const int l = t / 192, ks = (t % 192) / 24, cb = t % 24;
            __syncthreads();
            for (int i = tid; i < 9 * 128; i += NT) {
                const int r = i >> 7, k = i & 127;
                const float cv = (r < 8) ? p.in[I_C][r * 1024 + ks * 128 + k] : p.in[I_CCTX][ks * 128 + k];
                sc[i] = silu_f(cv);
            }
            __syncthreads();
            const int j = cb * 256 + tid;
            const float* w = p.in[I_WADA] + ((size_t)l * 1024 + ks * 128) * 6144 + j;
            float acc[9];
#pragma unroll
            for (int r = 0; r < 9; ++r) acc[r] = 0.f;
#pragma unroll 4
            for (int k = 0; k < 128; ++k) {
                const float wv = w[(size_t)k * 6144];
#pragma unroll
                for (int r = 0; r < 9; ++r) acc[r] += sc[r * 128 + k] * wv;
            }
#pragma unroll
            for (int r = 0; r < 9; ++r) modp[(((size_t)ks * 2 + l) * 9 + r) * 6144 + j] = acc[r];
        }
    }
    {
        float* rc = (float*)(ws + WS_ROPE); float* rs = rc + 2048 * 32;
        for (int i = blockIdx.x * NT + tid; i < 2048 * 32; i += gridDim.x * NT) {
            const int s = i >> 5, a = (i >> 4) & 1, pp = i & 15;
            const float pos = (float)(a == 0 ? (s >> 6) : (s & 63));
            const float inv = powf(10000.f, -(float)pp / 16.f);
            const float ang = pos * inv;
            rc[i] = cosf(ang); rs[i] = sinf(ang);
        }
    }
}
DEVI void phase_modred(const Params& p) {
    const float* modp = (const float*)(p.ws + WS_MODP);
    float* mod = (float*)(p.ws + WS_MOD);
    for (int i = blockIdx.x * NT + threadIdx.x; i < 2 * 9 * 6144; i += gridDim.x * NT) {
        const int l = i / (9 * 6144), j = i % 6144;
        float s = p.in[I_BADA][l * 6144 + j];
#pragma unroll
        for (int ks = 0; ks < 8; ++ks) s += modp[(size_t)ks * 2 * 9 * 6144 + i];
        mod[i] = s;
    }
}

DEVI void phase_norm(const Params& p, int l, int which, int nrows) {
    const int lane = threadIdx.x & 63, wave = threadIdx.x >> 6;
    const float* gain = p.in[which == 0 ? I_NORM1 : I_NORM2] + l * D;
    bf16_t* H = (bf16_t*)(p.ws + WS_H);
    for (int r = blockIdx.x * 4 + wave; r < nrows; r += gridDim.x * 4) {
        const float* xr = xrow_ptr(p, r);
        const int mr = row_modrow(r);
        const float* sh = mod_ptr(p, l, mr, which == 0 ? 0 : 3);
        const float* sc = mod_ptr(p, l, mr, which == 0 ? 1 : 4);
        float4 v[4]; float ss = 0.f;
#pragma unroll
        for (int i = 0; i < 4; ++i) { v[i] = *(const float4*)(xr + i * 256 + lane * 4); ss += v[i].x * v[i].x + v[i].y * v[i].y + v[i].z * v[i].z + v[i].w * v[i].w; }
        ss = wave_sum(ss);
        const float rs = rsqrtf(ss * (1.f / 1024.f) + 1e-6f);
#pragma unroll
        for (int i = 0; i < 4; ++i) {
            const int c = i * 256 + lane * 4;
            const float4 g = *(const float4*)(gain + c), a = *(const float4*)(sc + c), b = *(const float4*)(sh + c);
            const float y0 = v[i].x * rs * g.x * (1.f + a.x) + b.x, y1 = v[i].y * rs * g.y * (1.f + a.y) + b.y;
            const float y2 = v[i].z * rs * g.z * (1.f + a.z) + b.z, y3 = v[i].w * rs * g.w * (1.f + a.w) + b.w;
            uint2 o; o.x = cvt_pk_bf16(y0, y1); o.y = cvt_pk_bf16(y2, y3);
            *(uint2*)(H + (size_t)r * D + c) = o;
        }
    }
}

template <int EPI>
DEVI void phase_gemm(const Params& p, const bf16_t* __restrict__ A, const bf16_t* __restrict__ BT, int M, int Npad, int N,
                     bf16_t* C, int ldc, int l, unsigned char* smem) {
    constexpr int LDS_STRIDE = 72;
    bf16_t* As = (bf16_t*)smem;
    bf16_t* Bs = As + 128 * LDS_STRIDE;
    const int tid = threadIdx.x, lane = tid & 63, wave = tid >> 6;
    const int wm = wave >> 1, wn = wave & 1, r16 = lane & 15, q4 = lane >> 4;
    const int ntn = Npad / 128, tiles = (M / 128) * ntn;
    for (int t = blockIdx.x; t < tiles; t += gridDim.x) {
        const int m0 = (t / ntn) * 128, n0 = (t % ntn) * 128;
        f32x4 acc[4][4];
#pragma unroll
        for (int i = 0; i < 4; ++i)
#pragma unroll
            for (int j = 0; j < 4; ++j) acc[i][j] = (f32x4){0.f, 0.f, 0.f, 0.f};
        u32x4 ra[4], rb[4];
#pragma unroll
        for (int i = 0; i < 4; ++i) {
            const int c = tid + 256 * i, row = c >> 3, kc = c & 7;
            ra[i] = *(const u32x4*)(A + (size_t)(m0 + row) * 1024 + kc * 8);
            rb[i] = *(const u32x4*)(BT + (size_t)(n0 + row) * 1024 + kc * 8);
        }
        for (int kt = 0; kt < 16; ++kt) {
            __syncthreads();
#pragma unroll
            for (int i = 0; i < 4; ++i) {
                const int c = tid + 256 * i, row = c >> 3, kc = c & 7;
                *(u32x4*)(As + row * LDS_STRIDE + kc * 8) = ra[i];
                *(u32x4*)(Bs + row * LDS_STRIDE + kc * 8) = rb[i];
            }
            __syncthreads();
            {
                const int kn = (kt + 1 < 16) ? (kt + 1) : kt;
#pragma unroll
                for (int i = 0; i < 4; ++i) {
                    const int c = tid + 256 * i, row = c >> 3, kc = c & 7;
                    ra[i] = *(const u32x4*)(A + (size_t)(m0 + row) * 1024 + kn * 64 + kc * 8);
                    rb[i] = *(const u32x4*)(BT + (size_t)(n0 + row) * 1024 + kn * 64 + kc * 8);
                }
            }
#pragma unroll
            for (int ks = 0; ks < 2; ++ks) {
                bf16x8 af[4], bfr[4];
#pragma unroll
                for (int i = 0; i < 4; ++i) af[i] = *(const bf16x8*)(As + (wm * 64 + i * 16 + r16) * LDS_STRIDE + ks * 32 + q4 * 8);
#pragma unroll
                for (int j = 0; j < 4; ++j) bfr[j] = *(const bf16x8*)(Bs + (wn * 64 + j * 16 + r16) * LDS_STRIDE + ks * 32 + q4 * 8);
#pragma unroll
                for (int i = 0; i < 4; ++i)
#pragma unroll
                    for (int j = 0; j < 4; ++j) acc[i][j] = __builtin_amdgcn_mfma_f32_16x16x32_bf16(af[i], bfr[j], acc[i][j], 0, 0, 0);
            }
        }
#pragma unroll
        for (int i = 0; i < 4; ++i) {
#pragma unroll
            for (int rg = 0; rg < 4; ++rg) {
                const int row = m0 + wm * 64 + i * 16 + q4 * 4 + rg;
                if (EPI == 0) {
#pragma unroll
                    for (int j = 0; j < 4; ++j) {
                        const int col = n0 + wn * 64 + j * 16 + r16;
                        if (col < N) C[(size_t)row * ldc + col] = f2bf(acc[i][j][rg]);
                    }
                } else {
                    float* xr = xrow_ptr(p, row);
                    const float* g = mod_ptr(p, l, row_modrow(row), 2);
#pragma unroll
                    for (int j = 0; j < 4; ++j) {
                        const int col = n0 + wn * 64 + j * 16 + r16;
                        xr[col] += g[col] * acc[i][j][rg];
                    }
                }
            }
        }
    }
}

DEVI void gdn_prep_task(const Params& p, int l, int task) {
    const int lane = threadIdx.x & 63, wave = threadIdx.x >> 6;
    const bf16_t* P = (const bf16_t*)(p.ws + WS_P);
    float* GQ = (float*)(p.ws + WS_GQKV);
    float* GG = (float*)(p.ws + WS_GG);
    float* GB = (float*)(p.ws + WS_GBETA);
    const float* cw = p.in[I_CONVW] + (size_t)l * 5 * 1152;
    {
        const int r = task * 4 + wave;
        if (r >= NTOK) return;
        int s, L, base;
        if (r < NX) { s = r & 2047; L = SEQ; base = r - s; } else { s = (r - NX) & 255; L = LC; base = r - s; }
#pragma unroll 1
        for (int grp = 0; grp < 3; ++grp) {
            float acc[6];
#pragma unroll
            for (int j = 0; j < 6; ++j) acc[j] = 0.f;
#pragma unroll
            for (int tap = 0; tap < 5; ++tap) {
                const int ss = s + tap - 2;
                if (ss >= 0 && ss < L) {
                    const bf16_t* pr = P + (size_t)(base + ss) * INW + C_GQKV + grp * 384;
#pragma unroll
                    for (int j = 0; j < 6; ++j) acc[j] += cw[tap * 1152 + grp * 384 + j * 64 + lane] * bf2f(pr[j * 64 + lane]);
                }
            }
#pragma unroll
            for (int j = 0; j < 6; ++j) {
                float y = silu_f(acc[j]);
                if (grp < 2) { const float ss2 = wave_sum(y * y); y *= rsqrtf(ss2 + 1e-6f); }
                GQ[(size_t)r * 1152 + grp * 384 + j * 64 + lane] = y;
            }
        }
        if (lane < 12) {
            const int d = lane / 6, h = lane % 6;
            const bf16_t* pr = P + (size_t)r * INW + C_GBA;
            const float braw = bf2f(pr[d * 6 + h]), araw = bf2f(pr[12 + d * 6 + h]);
            const float beta = sigmoid_f(braw);
            const float g = -__expf(p.in[I_ALOG][l * 12 + d * 6 + h]) * softplus_f(araw + p.in[I_DTB][l * 12 + d * 6 + h]);
            GB[((size_t)d * NTOK + r) * 6 + h] = beta;
            GG[((size_t)d * NTOK + r) * 6 + h] = g;
        }
    }
}

DEVI void pool_task(const Params& p, int l, int t0row, unsigned char* smem) {
    const int tid = threadIdx.x;
    float* a = (float*)smem;
    float* pooled = a + 32 * 256;
    const bf16_t* P = (const bf16_t*)(p.ws + WS_P);
    bf16_t* Y = (bf16_t*)(p.ws + WS_Y);
    int s0, L, base;
    if (t0row < NX) { s0 = t0row & 2047; L = SEQ; base = t0row - s0; } else { s0 = (t0row - NX) & 255; L = LC; base = t0row - s0; }
    __syncthreads();
#pragma unroll
    for (int it = 0; it < 4; ++it) {
        const int c = tid + 256 * it, rr = c >> 5, cc = (c & 31) * 8;
        const int s = s0 - 8 + rr;
        uint4 v = make_uint4(0u, 0u, 0u, 0u);
        if (s >= 0 && s < L) v = *(const uint4*)(P + (size_t)(base + s) * INW + C_POOL + cc);
        float* dst = a + rr * 256 + cc;
        dst[0] = lo_f(v.x); dst[1] = hi_f(v.x); dst[2] = lo_f(v.y); dst[3] = hi_f(v.y);
        dst[4] = lo_f(v.z); dst[5] = hi_f(v.z); dst[6] = lo_f(v.w); dst[7] = hi_f(v.w);
    }
    __syncthreads();
    {
        const int ch = tid, gi = ch >> 6, w = 2 << gi;
        for (int tok = 0; tok < 16; ++tok) {
            const int s = s0 + tok;
            int lo = s - w / 2; if (lo < 0) lo = 0;
            int hi = s + w - w / 2; if (hi > L) hi = L;
            float sum = 0.f;
            for (int ss = lo; ss < hi; ++ss) sum += a[(ss - s0 + 8) * 256 + ch];
            pooled[tok * 256 + ch] = sum / (float)(hi - lo) - a[(tok + 8) * 256 + ch];
        }
    }
    __syncthreads();
    {
        const int e = tid, gi = e >> 6, ee = e & 63;
        const float* w = p.in[I_WPOOL] + ((size_t)(l * 4 + gi) * 64) * 64 + ee;
        float acc[16];
#pragma unroll
        for (int tok = 0; tok < 16; ++tok) acc[tok] = 0.f;
        for (int c = 0; c < 64; ++c) {
            const float wv = w[c * 64];
#pragma unroll
            for (int tok = 0; tok < 16; ++tok) acc[tok] += pooled[tok * 256 + gi * 64 + c] * wv;
        }
        const float ps = p.in[I_PSCALE][l * 256 + e];
#pragma unroll
        for (int tok = 0; tok < 16; ++tok) Y[(size_t)(t0row + tok) * D + e] = f2bf(acc[tok] * ps);
    }
}

DEVI void attn_task(const Params& p, int l, int qrow0, int qh, bool is_x, int b, int n, unsigned char* smem) {
    const int tid = threadIdx.x, lane = tid & 63, wave = tid >> 6;
    const int qi = wave * 32 + (lane & 31), dh = lane >> 5;
    const bf16_t* P = (const bf16_t*)(p.ws + WS_P);
    bf16_t* Y = (bf16_t*)(p.ws + WS_Y);
    const float* rc = (const float*)(p.ws + WS_ROPE); const float* rsn = rc + 2048 * 32;
    float* Ks = (float*)smem;
    float* Vs = Ks + 64 * 64;
    const int hk = qh / 3;
    float q[32];
    {
        const bf16_t* qp = P + (size_t)(qrow0 + qi) * INW + C_AQ + qh * 64 + dh * 32;
#pragma unroll
        for (int c = 0; c < 4; ++c) {
            const u32x4 v = *(const u32x4*)(qp + c * 8);
            q[c * 8 + 0] = lo_f(v.x); q[c * 8 + 1] = hi_f(v.x); q[c * 8 + 2] = lo_f(v.y); q[c * 8 + 3] = hi_f(v.y);
            q[c * 8 + 4] = lo_f(v.z); q[c * 8 + 5] = hi_f(v.z); q[c * 8 + 6] = lo_f(v.w); q[c * 8 + 7] = hi_f(v.w);
        }
        if (is_x) {
            const int s = (qrow0 + qi) & 2047;
#pragma unroll
            for (int pp = 0; pp < 16; ++pp) {
                const float c = rc[s * 32 + dh * 16 + pp], sn = rsn[s * 32 + dh * 16 + pp];
                const float x1 = q[pp], x2 = q[16 + pp];
                q[pp] = x1 * c - x2 * sn; q[16 + pp] = x2 * c + x1 * sn;
            }
        }
#pragma unroll
        for (int d = 0; d < 32; ++d) q[d] *= 0.125f;
    }
    float o[32];
#pragma unroll
    for (int d = 0; d < 32; ++d) o[d] = 0.f;
    float m = p.in[I_SINK][l * 6 + qh], lsum = 1.f;
    for (int sg = (is_x ? 0 : 3); sg < 5; ++sg) {
        if (sg == 0 && n == 0) continue;
        if (sg == 2 && n == 15) continue;
        const int krow0 = (sg < 3) ? (b * SEQ + (n - 1 + sg) * 128) : (NX + b * LC + (sg - 3) * 128);
        const int mtype = (sg == 0) ? 1 : ((sg == 2) ? 2 : 0);
        const int krope = (sg < 3) ? 1 : 0;
        for (int sub = 0; sub < 2; ++sub) {
            __syncthreads();
            {
                const int key = tid >> 2, a = (tid >> 1) & 1, ph = tid & 1;
                const int krow = krow0 + sub * 64 + key;
                const bf16_t* kp = P + (size_t)krow * INW + C_AK + hk * 64 + a * 32 + ph * 8;
                const bf16_t* vp = P + (size_t)krow * INW + C_AV + hk * 64 + a * 32 + ph * 8;
                const u32x4 k1 = *(const u32x4*)kp, k2 = *(const u32x4*)(kp + 16);
                const u32x4 v1 = *(const u32x4*)vp, v2 = *(const u32x4*)(vp + 16);
                float x1[8] = {lo_f(k1.x), hi_f(k1.x), lo_f(k1.y), hi_f(k1.y), lo_f(k1.z), hi_f(k1.z), lo_f(k1.w), hi_f(k1.w)};
                float x2[8] = {lo_f(k2.x), hi_f(k2.x), lo_f(k2.y), hi_f(k2.y), lo_f(k2.z), hi_f(k2.z), lo_f(k2.w), hi_f(k2.w)};
                if (krope) {
                    const int s = krow & 2047;
#pragma unroll
                    for (int j = 0; j < 8; ++j) {
                        const float c = rc[s * 32 + a * 16 + ph * 8 + j], sn = rsn[s * 32 + a * 16 + ph * 8 + j];
                        const float y1 = x1[j] * c - x2[j] * sn, y2 = x2[j] * c + x1[j] * sn;
                        x1[j] = y1; x2[j] = y2;
                    }
                }
                float* kd = Ks + key * 64 + a * 32 + ph * 8;
                float* vd = Vs + key * 64 + a * 32 + ph * 8;
#pragma unroll
                for (int j = 0; j < 8; ++j) { kd[j] = x1[j]; kd[16 + j] = x2[j]; }
                vd[0] = lo_f(v1.x); vd[1] = hi_f(v1.x); vd[2] = lo_f(v1.y); vd[3] = hi_f(v1.y); vd[4] = lo_f(v1.z); vd[5] = hi_f(v1.z); vd[6] = lo_f(v1.w); vd[7] = hi_f(v1.w);
                vd[16] = lo_f(v2.x); vd[17] = hi_f(v2.x); vd[18] = lo_f(v2.y); vd[19] = hi_f(v2.y); vd[20] = lo_f(v2.z); vd[21] = hi_f(v2.z); vd[22] = lo_f(v2.w); vd[23] = hi_f(v2.w);
            }
            __syncthreads();
            for (int kl = 0; kl < 64; ++kl) {
                const int j = sub * 64 + kl;
                const bool valid = (mtype == 0) || (mtype == 1 ? (j >= qi) : (j <= qi));
                const float* kr = Ks + kl * 64 + dh * 32;
                float sp = 0.f;
#pragma unroll
                for (int d = 0; d < 32; ++d) sp += q[d] * kr[d];
                float s = sp + __shfl_xor(sp, 32);
                s = valid ? s : -1e30f;
                if (s > m) {
                    const float alpha = __expf(m - s);
                    lsum *= alpha;
#pragma unroll
                    for (int d = 0; d < 32; ++d) o[d] *= alpha;
                    m = s;
                }
                const float pw = __expf(s - m);
                lsum += pw;
                const float* vr = Vs + kl * 64 + dh * 32;
#pragma unroll
                for (int d = 0; d < 32; ++d) o[d] += pw * vr[d];
            }
        }
    }
    {
        const float inv = 1.f / lsum;
        bf16_t* yp = Y + (size_t)(qrow0 + qi) * D + 640 + qh * 64 + dh * 32;
#pragma unroll
        for (int c = 0; c < 4; ++c) {
            u32x4 ov;
            ov.x = cvt_pk_bf16(o[c * 8 + 0] * inv, o[c * 8 + 1] * inv); ov.y = cvt_pk_bf16(o[c * 8 + 2] * inv, o[c * 8 + 3] * inv);
            ov.z = cvt_pk_bf16(o[c * 8 + 4] * inv, o[c * 8 + 5] * inv); ov.w = cvt_pk_bf16(o[c * 8 + 6] * inv, o[c * 8 + 7] * inv);
            *(u32x4*)(yp + c * 8) = ov;
        }
    }
}

DEVI void phase_mix1(const Params& p, int l, unsigned char* smem) {
    const bool need_ctx = (l == 0);
    const int n_prep = (NTOK + 3) / 4;
    const int n_pool = (need_ctx ? NTOK : NX) / 16;
    const int n_attx = NB * 16 * 6;
    const int n_attc = need_ctx ? NB * 2 * 6 : 0;
    const int total = n_prep + n_pool + n_attx + n_attc;
    for (int t = blockIdx.x; t < total; t += gridDim.x) {
#ifndef MIX_MASK
#define MIX_MASK 7
#endif
        if (t < n_prep) {
            if (MIX_MASK & 1) gdn_prep_task(p, l, t);
        } else if (t < n_prep + n_pool) {
            if (MIX_MASK & 2) pool_task(p, l, (t - n_prep) * 16, smem);
        } else if (t < n_prep + n_pool + n_attx) {
            const int u = t - n_prep - n_pool;
            const int b = u / 96, n = (u % 96) / 6, qh = u % 6;
            if (MIX_MASK & 4) attn_task(p, l, b * SEQ + n * 128, qh, true, b, n, smem);
        } else {
            const int u = t - n_prep - n_pool - n_attx;
            const int b = u / 12, qb = (u % 12) / 6, qh = u % 6;
            if (MIX_MASK & 4) attn_task(p, l, NX + b * LC + qb * 128, qh, false, b, 1, smem);
        }
    }
}

DEVI int gdn_step_row(int b, int dir, int step) {
    if (step < LC) return NX + b * LC + (dir ? (LC - 1 - step) : step);
    const int i = step - LC;
    return b * SEQ + (dir ? (SEQ - 1 - i) : i);
}
DEVI void phase_gdn_scan_seq(const Params& p, unsigned char* smem) {
    const int lane = threadIdx.x & 63, wave = threadIdx.x >> 6;
    const float* GQ = (const float*)(p.ws + WS_GQKV);
    const float* GG = (const float*)(p.ws + WS_GG);
    const float* GB = (const float*)(p.ws + WS_GBETA);
    float* GO = (float*)(p.ws + WS_GO);
    float* kq = (float*)smem + wave * 128;
    for (int c = blockIdx.x * 4 + wave; c < 96; c += gridDim.x * 4) {
        const int b = c / 12, h = (c % 12) >> 1, dir = c & 1;
        float S[64];
#pragma unroll
        for (int d = 0; d < 64; ++d) S[d] = 0.f;
        int row = gdn_step_row(b, dir, 0);
        float cq = GQ[(size_t)row * 1152 + h * 64 + lane], ck = GQ[(size_t)row * 1152 + 384 + h * 64 + lane], cv = GQ[(size_t)row * 1152 + 768 + h * 64 + lane];
        float cg = GG[((size_t)dir * NTOK + row) * 6 + h], cb = GB[((size_t)dir * NTOK + row) * 6 + h];
        for (int step = 0; step < LC + SEQ; ++step) {
            const int nstep = (step + 1 < LC + SEQ) ? step + 1 : step;
            const int nrow = gdn_step_row(b, dir, nstep);
            const float nq = GQ[(size_t)nrow * 1152 + h * 64 + lane], nk = GQ[(size_t)nrow * 1152 + 384 + h * 64 + lane], nv = GQ[(size_t)nrow * 1152 + 768 + h * 64 + lane];
            const float ng = GG[((size_t)dir * NTOK + nrow) * 6 + h], nb = GB[((size_t)dir * NTOK + nrow) * 6 + h];
            kq[lane] = ck; kq[64 + lane] = cq * 0.125f;
            __builtin_amdgcn_wave_barrier();
            const float eg = __expf(cg);
            float kS = 0.f;
#pragma unroll
            for (int d4 = 0; d4 < 16; ++d4) {
                const f32x4 kk = *(const f32x4*)(kq + d4 * 4);
                kS += kk.x * S[d4 * 4 + 0] + kk.y * S[d4 * 4 + 1] + kk.z * S[d4 * 4 + 2] + kk.w * S[d4 * 4 + 3];
            }
            const float tmp = cb * (cv - eg * kS);
            float ov = 0.f;
#pragma unroll
            for (int d4 = 0; d4 < 16; ++d4) {
                const f32x4 kk = *(const f32x4*)(kq + d4 * 4);
                const f32x4 qq = *(const f32x4*)(kq + 64 + d4 * 4);
                S[d4 * 4 + 0] = kk.x * tmp + eg * S[d4 * 4 + 0]; ov += qq.x * S[d4 * 4 + 0];
                S[d4 * 4 + 1] = kk.y * tmp + eg * S[d4 * 4 + 1]; ov += qq.y * S[d4 * 4 + 1];
                S[d4 * 4 + 2] = kk.z * tmp + eg * S[d4 * 4 + 2]; ov += qq.z * S[d4 * 4 + 2];
                S[d4 * 4 + 3] = kk.w * tmp + eg * S[d4 * 4 + 3]; ov += qq.w * S[d4 * 4 + 3];
            }
            GO[((size_t)dir * NTOK + row) * 384 + h * 64 + lane] = ov;
            __builtin_amdgcn_wave_barrier();
            row = nrow; cq = nq; ck = nk; cv = nv; cg = ng; cb = nb;
        }
    }
}

DEVI void phase_gdn_finish(const Params& p, int l, int nrows) {
    const int lane = threadIdx.x & 63, wave = threadIdx.x >> 6;
    const float* GO = (const float*)(p.ws + WS_GO);
    const bf16_t* P = (const bf16_t*)(p.ws + WS_P);
    bf16_t* Y = (bf16_t*)(p.ws + WS_Y);
    const float gn = p.in[I_GDNN][l * 64 + lane];
    for (int r = blockIdx.x * 4 + wave; r < nrows; r += gridDim.x * 4) {
#pragma unroll
        for (int h = 0; h < 6; ++h) {
            const float o = GO[(size_t)r * 384 + h * 64 + lane] + GO[((size_t)NTOK + r) * 384 + h * 64 + lane];
            const float ss = wave_sum(o * o);
            const float z = bf2f(P[(size_t)r * INW + C_GZ + h * 64 + lane]);
            const float y = o * rsqrtf(ss * (1.f / 64.f) + 1e-6f) * gn * silu_f(z);
            Y[(size_t)r * D + 256 + h * 64 + lane] = f2bf(y);
        }
    }
}

DEVI void phase_topk(const Params& p, int l, int nrows, unsigned char* smem) {
    const int tid = threadIdx.x, lane = tid & 63, wave = tid >> 6;
    const int r16 = lane & 15, q4 = lane >> 4;
    const bf16_t* Q = (const bf16_t*)(p.ws + WS_P);
    const bf16_t* KB = (const bf16_t*)(p.ws + WS_KB) + (size_t)l * 8 * 2 * 128 * 128;
    int* RIDX = (int*)(p.ws + WS_RIDX);
    float* RGATE = (float*)(p.ws + WS_RGATE);
    float* Ssm = (float*)smem;
    const int ntasks = (nrows / 32) * 8;
    for (int t = blockIdx.x; t < ntasks; t += gridDim.x) {
        const int row0 = (t >> 3) * 32, h = t & 7;
        __syncthreads();
        {
            const int mt = wave & 1, pp = wave >> 1;
            const bf16_t* qp = Q + (size_t)(row0 + mt * 16 + r16) * 2048 + h * 256 + pp * 128 + q4 * 8;
            bf16x8 af[4];
#pragma unroll
            for (int ks = 0; ks < 4; ++ks) af[ks] = *(const bf16x8*)(qp + ks * 32);
            const bf16_t* kp = KB + ((size_t)(h * 2 + pp) * 128 + r16) * 128 + q4 * 8;
#pragma unroll
            for (int kt = 0; kt < 8; ++kt) {
                f32x4 acc = (f32x4){0.f, 0.f, 0.f, 0.f};
#pragma unroll
                for (int ks = 0; ks < 4; ++ks) {
                    const bf16x8 bfr = *(const bf16x8*)(kp + (size_t)kt * 16 * 128 + ks * 32);
                    acc = __builtin_amdgcn_mfma_f32_16x16x32_bf16(af[ks], bfr, acc, 0, 0, 0);
                }
#pragma unroll
                for (int rg = 0; rg < 4; ++rg) Ssm[(mt * 16 + q4 * 4 + rg) * 256 + pp * 128 + kt * 16 + r16] = acc[rg];
            }
        }
        __syncthreads();
        for (int rr = 0; rr < 8; ++rr) {
            const int lr = wave * 8 + rr;
            const float* sr = Ssm + lr * 256;
            float sv[2]; int si[2];
            sv[0] = sv[1] = 0.f; si[0] = si[1] = 0;
#pragma unroll
            for (int pp = 0; pp < 2; ++pp) {
                float a0 = sr[pp * 128 + lane], a1 = sr[pp * 128 + 64 + lane];
                for (int r = 0; r < 16; ++r) {
                    const float mloc = fmaxf(a0, a1);
                    const float wm = wave_max(mloc);
                    const unsigned long long bal = __ballot(mloc == wm);
                    const int L = __builtin_amdgcn_readfirstlane(__ffsll((long long)bal) - 1);
                    const int which = (a0 == wm) ? 0 : 1;
                    const int idx_l = lane + 64 * which;
                    const int idx = __shfl(idx_l, L);
                    if (lane == L) { if (which == 0) a0 = -3.0e38f; else a1 = -3.0e38f; }
                    if (lane == r) { sv[pp] = wm; si[pp] = idx; }
                }
            }
            float cand[4];
#pragma unroll
            for (int jj = 0; jj < 4; ++jj) { const int c = lane + 64 * jj; cand[jj] = __shfl(sv[0], c >> 4) + __shfl(sv[1], c & 15); }
            float cv = 0.f; int ci = 0;
            for (int r = 0; r < 16; ++r) {
                const float mloc = fmaxf(fmaxf(cand[0], cand[1]), fmaxf(cand[2], cand[3]));
                const float wm = wave_max(mloc);
                const unsigned long long bal = __ballot(mloc == wm);
                const int L = __builtin_amdgcn_readfirstlane(__ffsll((long long)bal) - 1);
                const int which = (cand[0] == wm) ? 0 : ((cand[1] == wm) ? 1 : ((cand[2] == wm) ? 2 : 3));
                const int c_l = lane + 64 * which;
                const int cidx = __shfl(c_l, L);
                if (lane == L) {
                    if (which == 0) cand[0] = -3.0e38f; else if (which == 1) cand[1] = -3.0e38f; else if (which == 2) cand[2] = -3.0e38f; else cand[3] = -3.0e38f;
                }
                if (lane == r) { cv = wm; ci = cidx; }
            }
            const int i1 = __shfl(si[0], ci >> 4), i2 = __shfl(si[1], ci & 15);
            const float cmax = __shfl(cv, 0);
            const float e = (lane < 16) ? __expf(cv - cmax) : 0.f;
            const float esum = wave_sum(e);
            if (lane < 16) {
                const size_t o = (size_t)(row0 + lr) * 128 + h * 16 + lane;
                RIDX[o] = i1 * 128 + i2;
                RGATE[o] = e / esum;
            }
        }
    }
}

DEVI void phase_peer(const Params& p, int l, int nrows) {
    const int lane = threadIdx.x & 63, wave = threadIdx.x >> 6;
    const bf16_t* H = (const bf16_t*)(p.ws + WS_H);
    const bf16_t* UB = (const bf16_t*)(p.ws + WS_UB) + (size_t)l * NEXP * 1024;
    const bf16_t* VB = (const bf16_t*)(p.ws + WS_VB) + (size_t)l * NEXP * 1024;
    const int* RIDX = (const int*)(p.ws + WS_RIDX);
    const float* RGATE = (const float*)(p.ws + WS_RGATE);
    for (int r = blockIdx.x * 4 + wave; r < nrows; r += gridDim.x * 4) {
        float hv[16];
        {
            const uint4 a = *(const uint4*)(H + (size_t)r * D + lane * 8), b = *(const uint4*)(H + (size_t)r * D + 512 + lane * 8);
            hv[0] = lo_f(a.x); hv[1] = hi_f(a.x); hv[2] = lo_f(a.y); hv[3] = hi_f(a.y); hv[4] = lo_f(a.z); hv[5] = hi_f(a.z); hv[6] = lo_f(a.w); hv[7] = hi_f(a.w);
            hv[8] = lo_f(b.x); hv[9] = hi_f(b.x); hv[10] = lo_f(b.y); hv[11] = hi_f(b.y); hv[12] = lo_f(b.z); hv[13] = hi_f(b.z); hv[14] = lo_f(b.w); hv[15] = hi_f(b.w);
        }
        const int idx0 = RIDX[(size_t)r * 128 + lane], idx1 = RIDX[(size_t)r * 128 + 64 + lane];
        const float gt0 = RGATE[(size_t)r * 128 + lane], gt1 = RGATE[(size_t)r * 128 + 64 + lane];
        float acc[16];
#pragma unroll
        for (int i = 0; i < 16; ++i) acc[i] = 0.f;
        for (int k0 = 0; k0 < 128; k0 += 4) {
            uint4 ua[4], ub[4], va[4], vb[4]; float gt[4];
#pragma unroll
            for (int j = 0; j < 4; ++j) {
                const int k = k0 + j;
                const int e = __shfl(k < 64 ? idx0 : idx1, k & 63);
                gt[j] = __shfl(k < 64 ? gt0 : gt1, k & 63);
                const bf16_t* up = UB + (size_t)e * 1024 + lane * 8;
                const bf16_t* vp = VB + (size_t)e * 1024 + lane * 8;
                ua[j] = *(const uint4*)up; ub[j] = *(const uint4*)(up + 512);
                va[j] = *(const uint4*)vp; vb[j] = *(const uint4*)(vp + 512);
            }
#pragma unroll
            for (int j = 0; j < 4; ++j) {
                float s = lo_f(ua[j].x) * hv[0] + hi_f(ua[j].x) * hv[1] + lo_f(ua[j].y) * hv[2] + hi_f(ua[j].y) * hv[3]
                        + lo_f(ua[j].z) * hv[4] + hi_f(ua[j].z) * hv[5] + lo_f(ua[j].w) * hv[6] + hi_f(ua[j].w) * hv[7]
                        + lo_f(ub[j].x) * hv[8] + hi_f(ub[j].x) * hv[9] + lo_f(ub[j].y) * hv[10] + hi_f(ub[j].y) * hv[11]
                        + lo_f(ub[j].z) * hv[12] + hi_f(ub[j].z) * hv[13] + lo_f(ub[j].w) * hv[14] + hi_f(ub[j].w) * hv[15];
                s = wave_sum(s);
                const float w = gt[j] * gelu_f(s);
                acc[0] += w * lo_f(va[j].x); acc[1] += w * hi_f(va[j].x); acc[2] += w * lo_f(va[j].y); acc[3] += w * hi_f(va[j].y);
                acc[4] += w * lo_f(va[j].z); acc[5] += w * hi_f(va[j].z); acc[6] += w * lo_f(va[j].w); acc[7] += w * hi_f(va[j].w);
                acc[8] += w * lo_f(vb[j].x); acc[9] += w * hi_f(vb[j].x); acc[10] += w * lo_f(vb[j].y); acc[11] += w * hi_f(vb[j].y);
                acc[12] += w * lo_f(vb[j].z); acc[13] += w * hi_f(vb[j].z); acc[14] += w * lo_f(vb[j].w); acc[15] += w * hi_f(vb[j].w);
            }
        }
        float* xr = xrow_ptr(p, r);
        const float* g2 = mod_ptr(p, l, row_modrow(r), 5);
#pragma unroll
        for (int hf = 0; hf < 2; ++hf) {
            const int c = hf * 512 + lane * 8;
            float4 x0 = *(float4*)(xr + c), x1 = *(float4*)(xr + c + 4);
            const float4 ga = *(const float4*)(g2 + c), gb = *(const float4*)(g2 + c + 4);
            x0.x += ga.x * acc[hf * 8 + 0]; x0.y += ga.y * acc[hf * 8 + 1]; x0.z += ga.z * acc[hf * 8 + 2]; x0.w += ga.w * acc[hf * 8 + 3];
            x1.x += gb.x * acc[hf * 8 + 4]; x1.y += gb.y * acc[hf * 8 + 5]; x1.z += gb.z * acc[hf * 8 + 6]; x1.w += gb.w * acc[hf * 8 + 7];
            *(float4*)(xr + c) = x0; *(float4*)(xr + c + 4) = x1;
        }
    }
}

DEVI void phase_final(const Params& p) {
    const int lane = threadIdx.x & 63, wave = threadIdx.x >> 6;
    const float* gain = p.in[I_NORMF];
    for (int r = blockIdx.x * 4 + wave; r < NX; r += gridDim.x * 4) {
        float* xr = p.out + (size_t)r * D;
        float4 v[4]; float ss = 0.f;
#pragma unroll
        for (int i = 0; i < 4; ++i) { v[i] = *(const float4*)(xr + i * 256 + lane * 4); ss += v[i].x * v[i].x + v[i].y * v[i].y + v[i].z * v[i].z + v[i].w * v[i].w; }
        ss = wave_sum(ss);
        const float rs = rsqrtf(ss * (1.f / 1024.f) + 1e-6f);
#pragma unroll
        for (int i = 0; i < 4; ++i) {
            const int c = i * 256 + lane * 4;
            const float4 g = *(const float4*)(gain + c);
            float4 o; o.x = v[i].x * rs * g.x; o.y = v[i].y * rs * g.y; o.z = v[i].z * rs * g.z; o.w = v[i].w * rs * g.w;
            *(float4*)(xr + c) = o;
        }
    }
}

constexpr int N_PHASES = 23;
template <int K>
DEVI void run_kind(const Params& p, int l, unsigned char* smem) {
    unsigned char* ws = p.ws;
    const int nrows_act = (l == 0) ? NTOK : NX;
    if (K == 10) phase_prep(p, smem);
    if (K == 11) phase_modred(p);
    if (K == 12) phase_final(p);
    if (K == 0) phase_norm(p, l, 0, NTOK);
    if (K == 1) phase_gemm<0>(p, (const bf16_t*)(ws + WS_H), (const bf16_t*)(ws + WS_WINT) + (size_t)l * INWP * 1024, NTOK, INWP, INW, (bf16_t*)(ws + WS_P), INW, l, smem);
    if (K == 2) phase_mix1(p, l, smem);
    if (K == 3) phase_gdn_scan_seq(p, smem);
    if (K == 4) phase_gdn_finish(p, l, nrows_act);
    if (K == 5) phase_gemm<1>(p, (const bf16_t*)(ws + WS_Y), (const bf16_t*)(ws + WS_WOUTT) + (size_t)l * 1024 * 1024, nrows_act, 1024, 1024, nullptr, 0, l, smem);
    if (K == 6) phase_norm(p, l, 1, nrows_act);
    if (K == 7) phase_gemm<0>(p, (const bf16_t*)(ws + WS_H), (const bf16_t*)(ws + WS_WQT) + (size_t)l * 2048 * 1024, nrows_act, 2048, 2048, (bf16_t*)(ws + WS_P), 2048, l, smem);
    if (K == 8) phase_topk(p, l, nrows_act, smem);
    if (K == 9) phase_peer(p, l, nrows_act);
}

#if N_LAUNCH_MODE == 0
template <int K>
__global__ void __launch_bounds__(NT, 2) phase_kernel(Params p, int l) {
    __shared__ __attribute__((aligned(16))) unsigned char smem[SMEM_BYTES];
    run_kind<K>(p, l, smem);
}
#else
__global__ void __launch_bounds__(NT, 2) mk_kernel(Params p) {
    __shared__ __attribute__((aligned(16))) unsigned char smem[SMEM_BYTES];
    __shared__ uint4 xb_words;
    if (threadIdx.x == 0) xb_words = make_uint4(0u, 0u, 0u, 0u);
    __syncthreads();
    XcdBarrier bar = xcd_barrier_post((unsigned*)(p.ws + WS_BAR), (volatile LAS unsigned*)&xb_words);
    run_kind<10>(p, 0, smem); xcd_barrier(bar);
    run_kind<11>(p, 0, smem); xcd_barrier(bar);
#pragma unroll 1
    for (int l = 0; l < 2; ++l) {
        run_kind<0>(p, l, smem); xcd_barrier(bar);
        run_kind<1>(p, l, smem); xcd_barrier(bar);
        run_kind<2>(p, l, smem); xcd_barrier(bar);
        run_kind<3>(p, l, smem); xcd_barrier(bar);
        run_kind<4>(p, l, smem); xcd_barrier(bar);
        run_kind<5>(p, l, smem); xcd_barrier(bar);
        run_kind<6>(p, l, smem); xcd_barrier(bar);
        run_kind<7>(p, l, smem); xcd_barrier(bar);
        run_kind<8>(p, l, smem); xcd_barrier(bar);
        run_kind<9>(p, l, smem); xcd_barrier(bar);
    }
    run_kind<12>(p, 0, smem);
}
#endif

extern "C" void kernel_launch(void* const* d_in, const int* in_sizes, int n_in, void* d_out, int out_size, void* d_ws, size_t ws_size, hipStream_t stream) {
    if (n_in != 22 || ws_size < WS_TOTAL) { fprintf(stderr, "kernel_launch: unexpected n_in %d or ws_size %zu < %zu\n", n_in, ws_size, (size_t)WS_TOTAL); return; }
    Params p{};
    for (int i = 0; i < 22; ++i) p.in[i] = (const float*)d_in[i];
    p.out = (float*)d_out; p.ws = (unsigned char*)d_ws;
#if N_LAUNCH_MODE == 0
    const dim3 g(2048), b(NT);
    hipLaunchKernelGGL(phase_kernel<10>, g, b, 0, stream, p, 0);
    hipLaunchKernelGGL(phase_kernel<11>, g, b, 0, stream, p, 0);
    for (int l = 0; l < 2; ++l) {
        hipLaunchKernelGGL(phase_kernel<0>, g, b, 0, stream, p, l);
        hipLaunchKernelGGL(phase_kernel<1>, g, b, 0, stream, p, l);
        hipLaunchKernelGGL(phase_kernel<2>, g, b, 0, stream, p, l);
        hipLaunchKernelGGL(phase_kernel<3>, dim3(24), b, 0, stream, p, l);
        hipLaunchKernelGGL(phase_kernel<4>, g, b, 0, stream, p, l);
        hipLaunchKernelGGL(phase_kernel<5>, g, b, 0, stream, p, l);
        hipLaunchKernelGGL(phase_kernel<6>, g, b, 0, stream, p, l);
        hipLaunchKernelGGL(phase_kernel<7>, g, b, 0, stream, p, l);
        hipLaunchKernelGGL(phase_kernel<8>, g, b, 0, stream, p, l);
        hipLaunchKernelGGL(phase_kernel<9>, g, b, 0, stream, p, l);
    }
    hipLaunchKernelGGL(phase_kernel<12>, g, b, 0, stream, p, 0);
#else
    static int grid = 0;
    if (grid == 0) {
        int dev = 0, cus = 0, per_cu = 0;
        hipGetDevice(&dev);
        hipDeviceGetAttribute(&cus, hipDeviceAttributeMultiprocessorCount, dev);
        hipOccupancyMaxActiveBlocksPerMultiprocessor(&per_cu, (const void*)mk_kernel, NT, 0);
        if (per_cu > 2) per_cu = 2;
        if (per_cu < 1) per_cu = 1;
        grid = cus * per_cu;
    }
    hipMemsetAsync((unsigned char*)d_ws + WS_BAR, 0, 16384, stream);
    hipLaunchKernelGGL(mk_kernel, dim3(grid), dim3(NT), 0, stream, p);
#endif
}
```

```cpp
#include <hip/hip_runtime.h>
#include <stdint.h>
#include <stdio.h>

#define DEVI __device__ __forceinline__
typedef unsigned short bf16_t;
typedef __attribute__((ext_vector_type(8))) short bf16x8;
typedef __attribute__((ext_vector_type(4))) float f32x4;
typedef __attribute__((ext_vector_type(4))) unsigned u32x4;
typedef float f32x2 __attribute__((ext_vector_type(2)));

#ifndef N_LAUNCH_MODE
#define N_LAUNCH_MODE 1
#endif

constexpr int D = 1024, NB = 8, SEQ = 2048, LC = 256;
constexpr int NX = NB * SEQ, NC = NB * LC, NTOK = NX + NC;
constexpr int INW = 2456, INWP = 2560;
constexpr int C_POOL = 0, C_GQKV = 256, C_GZ = 1408, C_GBA = 1792, C_AQ = 1816, C_AK = 2200, C_AV = 2328;
constexpr int NEXP = 16384;
constexpr int NT = 256;
constexpr int SMEM_BYTES = 73984;

constexpr size_t al256(size_t x) { return (x + 255) & ~(size_t)255; }
constexpr size_t WS_BAR   = 0;
constexpr size_t WS_SMALL = 16384;
constexpr size_t WS_MODP  = WS_SMALL + 262144;
constexpr size_t WS_MOD   = WS_MODP  + al256((size_t)8 * 2 * 9 * 6144 * 4);
constexpr size_t WS_ROPE  = WS_MOD   + al256((size_t)2 * 9 * 6144 * 4);
constexpr size_t WS_WINT  = WS_ROPE  + al256((size_t)2 * 2048 * 32 * 4);
constexpr size_t WS_WOUTT = WS_WINT  + al256((size_t)2 * INWP * 1024 * 2);
constexpr size_t WS_WQT   = WS_WOUTT + al256((size_t)2 * 1024 * 1024 * 2);
constexpr size_t WS_KB    = WS_WQT   + al256((size_t)2 * 2048 * 1024 * 2);
constexpr size_t WS_UB    = WS_KB    + al256((size_t)2 * 8 * 2 * 128 * 128 * 2);
constexpr size_t WS_VB    = WS_UB    + al256((size_t)2 * NEXP * 768);
constexpr size_t WS_XC    = WS_VB    + al256((size_t)2 * NEXP * 768);
constexpr size_t WS_H     = WS_XC    + al256((size_t)NC * 1024 * 4);
constexpr size_t WS_Y     = WS_H     + al256((size_t)NTOK * 1024 * 2);
constexpr size_t WS_P     = WS_Y     + al256((size_t)NTOK * 1024 * 2);
constexpr size_t CH_TASK_BYTES = 40960;
constexpr size_t WS_CH    = WS_P     + al256((size_t)NTOK * INW * 2);
constexpr size_t WS_GL    = WS_CH    + al256((size_t)96 * 36 * CH_TASK_BYTES);
constexpr size_t WS_GO    = WS_GL    + al256((size_t)96 * 36 * 4);
constexpr size_t WS_RIDX  = WS_GO    + al256((size_t)2 * NTOK * 384 * 2);
constexpr size_t WS_RGATE = WS_RIDX  + al256((size_t)NTOK * 128 * 4);
constexpr size_t WS_SSP   = WS_RGATE + al256((size_t)NTOK * 128 * 4);
constexpr size_t WS_BQ    = WS_SSP   + al256((size_t)NTOK * 16 * 4);
constexpr size_t WS_TOTAL = WS_BQ    + al256((size_t)2 * 9 * 2048 * 4);

struct Params {
    const float* in[22];
    float* out;
    unsigned char* ws;
    int pad0, pad1;
};
constexpr int SP_NORM1 = 0, SP_NORM2 = 2048, SP_CONVW = 4096, SP_ALOG = 4096 + 11520, SP_DTB = SP_ALOG + 32, SP_GDNN = SP_DTB + 32,
              SP_WPOOL = SP_GDNN + 128, SP_PSCALE = SP_WPOOL + 32768, SP_SINK = SP_PSCALE + 512, SP_NORMF = SP_SINK + 32, SP_END = SP_NORMF + 1024;
static_assert(SP_END * 4 <= 262144, "small block");
enum { I_X = 0, I_C, I_CTX, I_CCTX, I_WADA, I_BADA, I_NORM1, I_NORM2, I_WIN, I_CONVW, I_ALOG, I_DTB, I_GDNN, I_WPOOL, I_PSCALE, I_SINK, I_WOUT, I_WQ, I_KEYS, I_PU, I_PV, I_NORMF };

DEVI int tidx() { int t = threadIdx.x; asm volatile("" : "+v"(t)); return t; }
DEVI float bf2f(bf16_t v) { return __uint_as_float(((unsigned)v) << 16); }
typedef __bf16 bf16x2_t __attribute__((ext_vector_type(2)));
DEVI unsigned cvt_pk_bf16(float lo, float hi) { bf16x2_t v; v.x = (__bf16)lo; v.y = (__bf16)hi; return __builtin_bit_cast(unsigned, v); }
DEVI bf16_t f2bf(float f) { return (bf16_t)(cvt_pk_bf16(f, 0.f) & 0xffffu); }
DEVI float lo_f(unsigned u) { return __uint_as_float(u << 16); }
DEVI float hi_f(unsigned u) { return __uint_as_float(u & 0xffff0000u); }
template <int M>
DEVI float xor_lane(float v) {
    if constexpr (M == 1) return __builtin_bit_cast(float, __builtin_amdgcn_update_dpp(0, __builtin_bit_cast(int, v), 0xB1, 0xF, 0xF, true));
    else if constexpr (M == 2) return __builtin_bit_cast(float, __builtin_amdgcn_update_dpp(0, __builtin_bit_cast(int, v), 0x4E, 0xF, 0xF, true));
    else if constexpr (M == 4) {
        const int h = __builtin_amdgcn_update_dpp(0, __builtin_bit_cast(int, v), 0x141, 0xF, 0xF, true);
        return __builtin_bit_cast(float, __builtin_amdgcn_update_dpp(0, h, 0x1B, 0xF, 0xF, true));
    }
    else if constexpr (M == 8) return __builtin_bit_cast(float, __builtin_amdgcn_update_dpp(0, __builtin_bit_cast(int, v), 0x128, 0xF, 0xF, true));
    else {
        typedef unsigned u32x2_t __attribute__((ext_vector_type(2)));
        const unsigned u = __builtin_bit_cast(unsigned, v);
        const u32x2_t r = (M == 16) ? __builtin_amdgcn_permlane16_swap(u, u, false, false) : __builtin_amdgcn_permlane32_swap(u, u, false, false);
        return __builtin_bit_cast(float, (__lane_id() & M) ? r.x : r.y);
    }
}
DEVI float wave_sum(float v) {
    v += xor_lane<1>(v); v += xor_lane<2>(v); v += xor_lane<4>(v); v += xor_lane<8>(v); v += xor_lane<16>(v); v += xor_lane<32>(v);
    return v;
}
DEVI float wave_max(float v) {
    v = fmaxf(v, xor_lane<1>(v)); v = fmaxf(v, xor_lane<2>(v)); v = fmaxf(v, xor_lane<4>(v)); v = fmaxf(v, xor_lane<8>(v));
    v = fmaxf(v, xor_lane<16>(v)); v = fmaxf(v, xor_lane<32>(v));
    return v;
}
DEVI float silu_f(float x) { return x * __builtin_amdgcn_rcpf(1.f + __expf(-x)); }
DEVI float sigmoid_f(float x) { return __builtin_amdgcn_rcpf(1.f + __expf(-x)); }
DEVI float softplus_f(float x) { return fmaxf(x, 0.f) + log1pf(__expf(-fabsf(x))); }
DEVI float gelu_f(float x) { return 0.5f * x * (1.f + erff(x * 0.70710678118654752f)); }

DEVI int row_modrow(int r) { return r < NX ? (r >> 11) : 8; }
DEVI float* xrow_ptr(const Params& p, int r) {
    return r < NX ? p.out + (size_t)r * D : (float*)(p.ws + WS_XC) + (size_t)(r - NX) * D;
}
DEVI const float* xin_ptr(const Params& p, int r) {
    return r < NX ? p.in[I_X] + (size_t)r * D : p.in[I_CTX] + (size_t)(r - NX) * D;
}
DEVI const float* sp_ptr(const Params& p, int off) { return (const float*)(p.ws + WS_SMALL) + off; }
DEVI const float* mod_ptr(const Params& p, int l, int mrow, int chunk) {
    return (const float*)(p.ws + WS_MOD) + ((size_t)(l * 9 + mrow) * 6 + chunk) * D;
}

#define XB_TMO      128
#define XB_XCNT(j)  (256  + 64 * (j))
#define XB_XSUB(j)  (1280 + 64 * (j))
#define XB_XGEN(j)  (2304 + 64 * (j))
#define XB_TOP      3328
#define XB_TOPGEN   3392
#define XCD_BAR_WORDS 3456
#define XB_SPIN_CAP (1u << 22)
#define LAS __attribute__((address_space(3)))
DEVI unsigned xb_ld(unsigned* p)              { return __hip_atomic_load(p, __ATOMIC_RELAXED, __HIP_MEMORY_SCOPE_AGENT); }
DEVI unsigned xb_add(unsigned* p, unsigned v) { return __hip_atomic_fetch_add(p, v, __ATOMIC_RELAXED, __HIP_MEMORY_SCOPE_AGENT); }
DEVI unsigned xb_xcc_id() { return (unsigned)__builtin_amdgcn_s_getreg((3 << 11) | 20) & 0xFu; }
#define XB_SPIN(cond, bar) do { unsigned _sp = 0; while (cond) { __builtin_amdgcn_s_sleep(1); \
    if ((++_sp & 255u) == 0u) { if (xb_ld(&(bar)[XB_TMO])) break; if (_sp > XB_SPIN_CAP) { atomicAdd(&(bar)[XB_TMO], 1u); break; } } } } while (0)
struct XcdBarrier { unsigned* bar; unsigned x; volatile LAS unsigned* st; };
DEVI XcdBarrier xcd_barrier_post(unsigned* bar, volatile LAS unsigned* st) {
    XcdBarrier b; b.bar = bar; b.x = xb_xcc_id(); b.st = st;
    if (threadIdx.x == 0) (void)xb_add(&bar[XB_XCNT(b.x)], 1u);
    return b;
}
DEVI void xcd_barrier_complete(unsigned* bar, unsigned x, unsigned& nloc, unsigned& nx) {
    const unsigned G = gridDim.x * gridDim.y * gridDim.z;
    unsigned sum, cnt, mine, sp = 0u;
    for (;;) {
        sum = 0u; cnt = 0u; mine = 0u;
#pragma unroll
        for (unsigned j = 0; j < 16; ++j) { const unsigned c = xb_ld(&bar[XB_XCNT(j)]); sum += c; cnt += (c > 0u) ? 1u : 0u; mine = (j == x) ? c : mine; }
        if (sum == G) break;
        __builtin_amdgcn_s_sleep(1);
        if ((++sp & 255u) == 0u) { if (xb_ld(&bar[XB_TMO])) break; if (sp > XB_SPIN_CAP) { atomicAdd(&bar[XB_TMO], 1u); break; } }
    }
    nloc = mine > 0u ? mine : 1u; nx = cnt > 0u ? cnt : 1u;
}
DEVI void xcd_barrier_census(const XcdBarrier& b) {
    if (threadIdx.x == 0) {
        unsigned nloc, nx;
        xcd_barrier_complete(b.bar, b.x, nloc, nx);
        b.st[0] = nloc; b.st[1] = nx;
    }
    __syncthreads();
}
DEVI void xcd_barrier(const XcdBarrier& b_in) {
    XcdBarrier b; b.bar = b_in.bar; b.st = b_in.st; b.x = xb_xcc_id();
    asm volatile("s_waitcnt vmcnt(0)" ::: "memory");
    __syncthreads();
    if (threadIdx.x == 0) {
        unsigned* bar = b.bar;
        __builtin_amdgcn_s_waitcnt(0);
        const unsigned nloc = b.st[0], nx = b.st[1];
        const unsigned old = xb_add(&bar[XB_XSUB(b.x)], 1u);
        const unsigned gen = old / nloc;
        if (old + 1u == (gen + 1u) * nloc) {
            __builtin_amdgcn_fence(__ATOMIC_RELEASE, "agent");
            asm volatile("s_waitcnt vmcnt(0)" ::: "memory");
            const unsigned og = xb_add(&bar[XB_TOP], 1u);
            const unsigned tg = og / nx;
            if (og + 1u == (tg + 1u) * nx) xb_add(&bar[XB_TOPGEN], 1u);
            else XB_SPIN(xb_ld(&bar[XB_TOPGEN]) == tg, bar);
            __builtin_amdgcn_fence(__ATOMIC_ACQUIRE, "agent");
            xb_add(&bar[XB_XGEN(b.x)], 1u);
            asm volatile("s_waitcnt vmcnt(0)" ::: "memory");
        } else {
            XB_SPIN(xb_ld(&bar[XB_XGEN(b.x)]) == gen, bar);
            __builtin_amdgcn_fence(__ATOMIC_ACQUIRE, "agent");
            asm volatile("s_waitcnt vmcnt(0)" ::: "memory");
        }
    }
    __syncthreads();
}

DEVI void cvt_bf16_job(const float* __restrict__ src, bf16_t* __restrict__ dst, size_t n) {
    const size_t n8 = n >> 3;
    for (size_t i = (size_t)blockIdx.x * NT + tidx(); i < n8; i += (size_t)gridDim.x * NT) {
        const float4 a = ((const float4*)src)[2 * i], b = ((const float4*)src)[2 * i + 1];
        uint4 o; o.x = cvt_pk_bf16(a.x, a.y); o.y = cvt_pk_bf16(a.z, a.w); o.z = cvt_pk_bf16(b.x, b.y); o.w = cvt_pk_bf16(b.z, b.w);
        ((uint4*)dst)[i] = o;
    }
}
typedef float f32x16 __attribute__((ext_vector_type(16)));
typedef float f32x32 __attribute__((ext_vector_type(32)));
typedef unsigned u32x6 __attribute__((ext_vector_type(6)));
typedef unsigned u32x3 __attribute__((ext_vector_type(3)));
DEVI void cvt_fp6_job(const float* __restrict__ src, unsigned char* __restrict__ dst, size_t n, float scale) {
    const size_t n32 = n >> 5;
    for (size_t i = (size_t)blockIdx.x * NT + tidx(); i < n32; i += (size_t)gridDim.x * NT) {
        f32x16 x, y;
#pragma unroll
        for (int q = 0; q < 4; ++q) {
            const float4 a = ((const float4*)src)[8 * i + q], b = ((const float4*)src)[8 * i + 4 + q];
            x[2 * q] = a.x * scale; y[2 * q] = a.y * scale; x[2 * q + 1] = a.z * scale; y[2 * q + 1] = a.w * scale;
            x[8 + 2 * q] = b.x * scale; y[8 + 2 * q] = b.y * scale; x[8 + 2 * q + 1] = b.z * scale; y[8 + 2 * q + 1] = b.w * scale;
        }
        const u32x6 w = __builtin_amdgcn_cvt_scalef32_2xpk16_fp6_f32(x, y, 1.0f);
        uint2* o = (uint2*)(dst + i * 24);
        o[0] = make_uint2(w[0], w[1]); o[1] = make_uint2(w[2], w[3]); o[2] = make_uint2(w[4], w[5]);
    }
}
DEVI void transpose_tile(const float* __restrict__ src, bf16_t* __restrict__ dst, int Nsrc, int k0, int n0, unsigned char* smem) {
    float* tile = (float*)smem;
    const int tid = tidx();
    __syncthreads();
    float4 tv[4];
#pragma unroll
    for (int it = 0; it < 4; ++it) {
        const int kk = it * 16 + (tid >> 4), nn = (tid & 15) * 4;
        tv[it] = (n0 + nn < Nsrc) ? *(const float4*)(src + (size_t)(k0 + kk) * Nsrc + n0 + nn) : make_float4(0.f, 0.f, 0.f, 0.f);
    }
#pragma unroll
    for (int it = 0; it < 4; ++it) {
        const int kk = it * 16 + (tid >> 4), nn = (tid & 15) * 4;
        float* d = tile + kk * 65 + nn;
        d[0] = tv[it].x; d[1] = tv[it].y; d[2] = tv[it].z; d[3] = tv[it].w;
    }
    __syncthreads();
#pragma unroll
    for (int it = 0; it < 2; ++it) {
        const int nn = it * 32 + (tid >> 3), kc = (tid & 7) * 8;
        float v[8];
#pragma unroll
        for (int j = 0; j < 8; ++j) v[j] = tile[(kc + j) * 65 + nn];
        uint4 o; o.x = cvt_pk_bf16(v[0], v[1]); o.y = cvt_pk_bf16(v[2], v[3]); o.z = cvt_pk_bf16(v[4], v[5]); o.w = cvt_pk_bf16(v[6], v[7]);
        *(uint4*)(dst + (size_t)(n0 + nn) * 1024 + k0 + kc) = o;
    }
}
DEVI void phase_prep(const Params& p, unsigned char* smem) {
    const int tid = tidx();
    unsigned char* ws = p.ws;
    {
        float* sp = (float*)(ws + WS_SMALL);
        const int gt = blockIdx.x * NT + tid, gs = gridDim.x * NT;
        for (int i = gt; i < 2048; i += gs) { sp[SP_NORM1 + i] = p.in[I_NORM1][i]; sp[SP_NORM2 + i] = p.in[I_NORM2][i]; }
        for (int i = gt; i < 11520; i += gs) sp[SP_CONVW + i] = p.in[I_CONVW][i];
        for (int i = gt; i < 24; i += gs) { sp[SP_ALOG + i] = p.in[I_ALOG][i]; sp[SP_DTB + i] = p.in[I_DTB][i]; }
        for (int i = gt; i < 128; i += gs) sp[SP_GDNN + i] = p.in[I_GDNN][i];
        for (int i = gt; i < 32768; i += gs) { const int lg = i >> 12, e = (i >> 6) & 63, c = i & 63; ((bf16_t*)(sp + SP_WPOOL))[i] = f2bf(p.in[I_WPOOL][(lg * 64 + c) * 64 + e]); }
        for (int i = gt; i < 512; i += gs) sp[SP_PSCALE + i] = p.in[I_PSCALE][i];
        for (int i = gt; i < 12; i += gs) sp[SP_SINK + i] = p.in[I_SINK][i];
        for (int i = gt; i < 1024; i += gs) sp[SP_NORMF + i] = p.in[I_NORMF][i];
    }
    cvt_bf16_job(p.in[I_KEYS], (bf16_t*)(ws + WS_KB), (size_t)2 * 8 * 2 * 128 * 128);
    cvt_fp6_job(p.in[I_PU], ws + WS_UB, (size_t)2 * NEXP * 1024, 64.f);
    cvt_fp6_job(p.in[I_PV], ws + WS_VB, (size_t)2 * NEXP * 1024, 2.f);
    {
        const int T_IN = 16 * (INWP / 64), T_OUT = 16 * 16, T_Q = 16 * 32;
        const int total = 2 * (T_IN + T_OUT + T_Q);
        for (int t = blockIdx.x; t < total; t += gridDim.x) {
            int l = t / (T_IN + T_OUT + T_Q), u = t % (T_IN + T_OUT + T_Q);
            if (u < T_IN) {
                const int kt = u / (INWP / 64), nt = u % (INWP / 64);
                transpose_tile(p.in[I_WIN] + (size_t)l * 1024 * INW, (bf16_t*)(ws + WS_WINT) + (size_t)l * INWP * 1024, INW, kt * 64, nt * 64, smem);
            } else if (u < T_IN + T_OUT) {
                u -= T_IN; const int kt = u / 16, nt = u % 16;
                transpose_tile(p.in[I_WOUT] + (size_t)l * 1024 * 1024, (bf16_t*)(ws + WS_WOUTT) + (size_t)l * 1024 * 1024, 1024, kt * 64, nt * 64, smem);
            } else {
                u -= T_IN + T_OUT; const int kt = u / 32, nt = u % 32;
                transpose_tile(p.in[I_WQ] + (size_t)l * 1024 * 2048, (bf16_t*)(ws + WS_WQT) + (size_t)l * 2048 * 1024, 2048, kt * 64, nt * 64, smem);
            }
        }
    }
    {
        float* sc = (float*)smem;
        float* modp = (float*)(ws + WS_MODP);
        for (int t = blockIdx.x; t < 2 * 8 * 24; t += gridDim.x) {
            const int l = t / 192, ks = (t % 192) / 24, cb = t % 24;
            __syncthreads();
            for (int i = tid; i < 9 * 128; i += NT) {
                const int r = i >> 7, k = i & 127;
                const float cv = (r < 8) ? p.in[I_C][r * 1024 + ks * 128 + k] : p.in[I_CCTX][ks * 128 + k];
                sc[i] = silu_f(cv);
            }
            __syncthreads();
            const int j = cb * 256 + tid;
            const float* w = p.in[I_WADA] + ((size_t)l * 1024 + ks * 128) * 6144 + j;
            float acc[9];
#pragma unroll
            for (int r = 0; r < 9; ++r) acc[r] = 0.f;
#pragma unroll 1
            for (int k0 = 0; k0 < 128; k0 += 32) {
                float wv[32];
#pragma unroll
                for (int kk = 0; kk < 32; ++kk) wv[kk] = w[(size_t)(k0 + kk) * 6144];
#pragma unroll
                for (int kk = 0; kk < 32; ++kk)
#pragma unroll
                    for (int r = 0; r < 9; ++r) acc[r] += sc[r * 128 + k0 + kk] * wv[kk];
            }
#pragma unroll
            for (int r = 0; r < 9; ++r) modp[(((size_t)ks * 2 + l) * 9 + r) * 6144 + j] = acc[r] + (ks == 0 ? p.in[I_BADA][l * 6144 + j] : 0.f);
        }
    }
    {
        float* rc = (float*)(ws + WS_ROPE); float* rs = rc + 2048 * 32;
        for (int i = blockIdx.x * NT + tid; i < 2048 * 32; i += gridDim.x * NT) {
            const int s = i >> 5, a = (i >> 4) & 1, pp = i & 15;
            const float pos = (float)(a == 0 ? (s >> 6) : (s & 63));
            const float inv = powf(10000.f, -(float)pp / 16.f);
            const float ang = pos * inv;
            rc[i] = cosf(ang); rs[i] = sinf(ang);
        }
    }
}
DEVI void phase_modred(const Params& p) {
    const float* modp = (const float*)(p.ws + WS_MODP);
    float* mod = (float*)(p.ws + WS_MOD);
    for (int i = blockIdx.x * NT + tidx(); i < 2 * 9 * 6144; i += gridDim.x * NT) {
        float s = 0.f;
#pragma unroll
        for (int ks = 0; ks < 8; ++ks) s += modp[(size_t)ks * 2 * 9 * 6144 + i];
        mod[i] = s;
    }
}

DEVI void phase_norm(const Params& p, int l, int which, int nrows) {
    const int lane = tidx() & 63, wave = tidx() >> 6;
    const float* gain = sp_ptr(p, (which == 0 ? SP_NORM1 : SP_NORM2) + l * D);
    bf16_t* H = (bf16_t*)(p.ws + WS_H);
    for (int r = blockIdx.x * 4 + wave; r < nrows; r += gridDim.x * 4) {
        const float* xr = (l == 0 && which == 0) ? xin_ptr(p, r) : xrow_ptr(p, r);
        const int mr = row_modrow(r);
        const float* sh = mod_ptr(p, l, mr, which == 0 ? 0 : 3);
        const float* sc = mod_ptr(p, l, mr, which == 0 ? 1 : 4);
        float4 v[4]; float ss = 0.f;
#pragma unroll
        for (int i = 0; i < 4; ++i) { v[i] = *(const float4*)(xr + i * 256 + lane * 4); ss += v[i].x * v[i].x + v[i].y * v[i].y + v[i].z * v[i].z + v[i].w * v[i].w; }
        ss = wave_sum(ss);
        const float rs = rsqrtf(ss * (1.f / 1024.f) + 1e-6f);
#pragma unroll
        for (int i = 0; i < 4; ++i) {
            const int c = i * 256 + lane * 4;
            const float4 g = *(const float4*)(gain + c), a = *(const float4*)(sc + c), b = *(const float4*)(sh + c);
            const float y0 = v[i].x * rs * g.x * (1.f + a.x) + b.x, y1 = v[i].y * rs * g.y * (1.f + a.y) + b.y;
            const float y2 = v[i].z * rs * g.z * (1.f + a.z) + b.z, y3 = v[i].w * rs * g.w * (1.f + a.w) + b.w;
            uint2 o; o.x = cvt_pk_bf16(y0, y1); o.y = cvt_pk_bf16(y2, y3);
            *(uint2*)(H + (size_t)r * D + c) = o;
        }
    }
}

DEVI void phase_qbias(const Params& p) {
    const int lane = tidx() & 63, wave = tidx() >> 6;
    float* BQ = (float*)(p.ws + WS_BQ);
    for (int u = blockIdx.x * 4 + wave; u < 2 * 2048; u += gridDim.x * 4) {
        const int l = u >> 11, n = u & 2047;
        const bf16_t* wr = (const bf16_t*)(p.ws + WS_WQT) + ((size_t)l * 2048 + n) * 1024 + lane * 16;
        const u32x4 a = *(const u32x4*)wr, b = *(const u32x4*)(wr + 8);
        const float w[16] = {lo_f(a.x), hi_f(a.x), lo_f(a.y), hi_f(a.y), lo_f(a.z), hi_f(a.z), lo_f(a.w), hi_f(a.w),
                             lo_f(b.x), hi_f(b.x), lo_f(b.y), hi_f(b.y), lo_f(b.z), hi_f(b.z), lo_f(b.w), hi_f(b.w)};
#pragma unroll 1
        for (int mr = 0; mr < 9; ++mr) {
            const float* sh = mod_ptr(p, l, mr, 3) + lane * 16;
            float s = 0.f;
#pragma unroll
            for (int q = 0; q < 4; ++q) { const float4 v = *(const float4*)(sh + q * 4); s += v.x * w[q * 4] + v.y * w[q * 4 + 1] + v.z * w[q * 4 + 2] + v.w * w[q * 4 + 3]; }
            s = wave_sum(s);
            if (lane == 0) BQ[((size_t)l * 9 + mr) * 2048 + n] = s;
        }
    }
}

template <int EPI>
DEVI void phase_gemm(const Params& p, const bf16_t* __restrict__ A, const bf16_t* __restrict__ BT, int M, int Npad, int N,
                     bf16_t* C, int ldc, int l, unsigned char* smem) {
    constexpr int TILE_ELEMS = 128 * 64;
    bf16_t* lds = (bf16_t*)smem;
    const int tid = tidx(), lane = tid & 63, wave = __builtin_amdgcn_readfirstlane(tid >> 6);
    const int wm = wave >> 1, wn = wave & 1, r16 = lane & 15, q4 = lane >> 4;
    const int ntn = Npad / 128, tiles = (M / 128) * ntn;
    const int srow = lane >> 3, spc = lane & 7;
    const int nrb = M / 128, G8 = gridDim.x >> 3;
    const bool xcd_order = ((gridDim.x & 7) == 0) && (nrb % 8 == 0);
    const int rb_per = nrb >> 3, part_tiles = rb_per * ntn;
    const int xcd = blockIdx.x & 7, widx = blockIdx.x >> 3;
    const int my_first = xcd_order ? widx : (int)blockIdx.x, my_step = xcd_order ? G8 : (int)gridDim.x, my_end = xcd_order ? part_tiles : tiles;
    for (int tt = my_first; tt < my_end; tt += my_step) {
        const int t = xcd_order ? (xcd * part_tiles + tt) : tt;
        const int m0 = (t / ntn) * 128, n0 = (t % ntn) * 128;
        f32x4 acc[4][4];
#pragma unroll
        for (int i = 0; i < 4; ++i)
#pragma unroll
            for (int j = 0; j < 4; ++j) acc[i][j] = (f32x4){0.f, 0.f, 0.f, 0.f};
        const bf16_t* ag[4]; const bf16_t* bg[4];
#pragma unroll
        for (int i = 0; i < 4; ++i) {
            const int row = (i * 4 + wave) * 8 + srow, c = spc ^ ((row >> 1) & 7);
            ag[i] = A + (size_t)(m0 + row) * 1024 + c * 8;
            bg[i] = BT + (size_t)(n0 + row) * 1024 + c * 8;
        }
#define GEMM_STAGE(buf, kt) do { _Pragma("unroll") for (int i = 0; i < 4; ++i) { \
            __builtin_amdgcn_global_load_lds((const unsigned*)(ag[i] + (kt) * 64), (unsigned*)(lds + (buf) * 2 * TILE_ELEMS + (i * 4 + wave) * 8 * 64), 16, 0, 0); \
            __builtin_amdgcn_global_load_lds((const unsigned*)(bg[i] + (kt) * 64), (unsigned*)(lds + (buf) * 2 * TILE_ELEMS + TILE_ELEMS + (i * 4 + wave) * 8 * 64), 16, 0, 0); } } while (0)
        __syncthreads();
        GEMM_STAGE(0, 0);
        __syncthreads();
        for (int kt = 0; kt < 16; ++kt) {
            const bf16_t* As = lds + (kt & 1) * 2 * TILE_ELEMS;
            const bf16_t* Bs = As + TILE_ELEMS;
            if (kt + 1 < 16) GEMM_STAGE((kt + 1) & 1, kt + 1);
            bf16x8 af[2][4], bfr[2][4];
#define LDA(ks, i) { const int r = wm * 64 + (i) * 16 + r16; af[ks][i] = *(const bf16x8*)(As + r * 64 + ((((ks) * 4 + q4) ^ ((r >> 1) & 7)) << 3)); }
#define LDB(ks, j) { const int r = wn * 64 + (j) * 16 + r16; bfr[ks][j] = *(const bf16x8*)(Bs + r * 64 + ((((ks) * 4 + q4) ^ ((r >> 1) & 7)) << 3)); }
            LDA(0, 0) LDB(0, 0) LDB(0, 1) LDB(0, 2) LDB(0, 3) LDA(0, 1) LDA(0, 2) LDA(0, 3)
            LDA(1, 0) LDB(1, 0) LDB(1, 1) LDB(1, 2) LDA(1, 1) LDA(1, 2) LDA(1, 3)
            __builtin_amdgcn_sched_barrier(0);
#pragma unroll
            for (int j = 0; j < 4; ++j) acc[0][j] = __builtin_amdgcn_mfma_f32_16x16x32_bf16(bfr[0][j], af[0][0], acc[0][j], 0, 0, 0);
            __builtin_amdgcn_sched_barrier(0);
            LDB(1, 3)
            __builtin_amdgcn_sched_barrier(0);
#pragma unroll
            for (int i = 1; i < 4; ++i)
#pragma unroll
                for (int j = 0; j < 4; ++j) acc[i][j] = __builtin_amdgcn_mfma_f32_16x16x32_bf16(bfr[0][j], af[0][i], acc[i][j], 0, 0, 0);
#pragma unroll
            for (int i = 0; i < 4; ++i)
#pragma unroll
                for (int j = 0; j < 4; ++j) acc[i][j] = __builtin_amdgcn_mfma_f32_16x16x32_bf16(bfr[1][j], af[1][i], acc[i][j], 0, 0, 0);
#undef LDA
#undef LDB
            __builtin_amdgcn_sched_barrier(0);
            __syncthreads();
        }
#undef GEMM_STAGE
        if (EPI == 0) {
            constexpr int CS = 136;
            bf16_t* Cs = lds;
#pragma unroll
            for (int i = 0; i < 4; ++i)
#pragma unroll
                for (int j = 0; j < 4; ++j) {
                    uint2 pk; pk.x = cvt_pk_bf16(acc[i][j][0], acc[i][j][1]); pk.y = cvt_pk_bf16(acc[i][j][2], acc[i][j][3]);
                    *(uint2*)(Cs + (wm * 64 + i * 16 + r16) * CS + wn * 64 + j * 16 + q4 * 4) = pk;
                }
            __syncthreads();
#pragma unroll
            for (int it = 0; it < 8; ++it) {
                const int c = tid + 256 * it, row = c >> 4, cc = c & 15;
                if (n0 + cc * 8 < N) *(u32x4*)(C + (size_t)(m0 + row) * ldc + n0 + cc * 8) = *(const u32x4*)(Cs + row * CS + cc * 8);
            }
        } else if (EPI == 1) {
            constexpr int FS = 132;
            float* Fs = (float*)lds;
            float* SSP = (float*)(p.ws + WS_SSP);
            const float* gn2 = sp_ptr(p, SP_NORM2 + l * D);
#pragma unroll
            for (int i = 0; i < 4; ++i)
#pragma unroll
                for (int j = 0; j < 4; ++j) *(f32x4*)(Fs + (wm * 64 + i * 16 + r16) * FS + wn * 64 + j * 16 + q4 * 4) = acc[i][j];
            __syncthreads();
#pragma unroll 4
            for (int it = 0; it < 16; ++it) {
                const int c = tid + 256 * it, lrow = c >> 5, cc = (c & 31) * 4;
                const int row = m0 + lrow, col = n0 + cc;
                float* xr = xrow_ptr(p, row);
                const float* xs = (l == 0) ? xin_ptr(p, row) : xr;
                const int mr = row_modrow(row);
                const f32x4 a4 = *(const f32x4*)(Fs + lrow * FS + cc);
                const float4 x4 = *(const float4*)(xs + col), g4v = *(const float4*)(mod_ptr(p, l, mr, 2) + col);
                const float4 s4 = *(const float4*)(mod_ptr(p, l, mr, 4) + col), n4 = *(const float4*)(gn2 + col);
                const float4 xn = make_float4(x4.x + g4v.x * a4.x, x4.y + g4v.y * a4.y, x4.z + g4v.z * a4.z, x4.w + g4v.w * a4.w);
                *(float4*)(xr + col) = xn;
                uint2 hp;
                hp.x = cvt_pk_bf16(xn.x * n4.x * (1.f + s4.x), xn.y * n4.y * (1.f + s4.y));
                hp.y = cvt_pk_bf16(xn.z * n4.z * (1.f + s4.z), xn.w * n4.w * (1.f + s4.w));
                *(uint2*)(C + (size_t)row * ldc + col) = hp;
                float ssq = xn.x * xn.x + xn.y * xn.y + xn.z * xn.z + xn.w * xn.w;
                ssq += xor_lane<1>(ssq); ssq += xor_lane<2>(ssq); ssq += xor_lane<4>(ssq); ssq += xor_lane<8>(ssq); ssq += xor_lane<16>(ssq);
                if ((lane & 31) == 0) SSP[(size_t)row * 8 + (n0 >> 7)] = ssq;
            }
        } else {
            constexpr int CS = 136;
            bf16_t* Cs = lds;
            float* rsv = (float*)(lds + 128 * CS);
            const float* SSP = (const float*)(p.ws + WS_SSP);
            const float* BQ = (const float*)(p.ws + WS_BQ) + (size_t)l * 9 * 2048;
            if (tid < 128) {
                const f32x4* sp4 = (const f32x4*)(SSP + (size_t)(m0 + tid) * 8);
                const f32x4 a = sp4[0], b = sp4[1];
                const float ss = ((a.x + a.y) + (a.z + a.w)) + ((b.x + b.y) + (b.z + b.w));
                rsv[tid] = rsqrtf(ss * (1.f / 1024.f) + 1e-6f);
            }
            __syncthreads();
#pragma unroll
            for (int i = 0; i < 4; ++i) {
                const int lrow = wm * 64 + i * 16 + r16;
                const float rs = rsv[lrow];
                const float* bq = BQ + (size_t)row_modrow(m0 + lrow) * 2048 + n0 + wn * 64 + q4 * 4;
#pragma unroll
                for (int j = 0; j < 4; ++j) {
                    const float4 b4 = *(const float4*)(bq + j * 16);
                    uint2 pk;
                    pk.x = cvt_pk_bf16(rs * acc[i][j][0] + b4.x, rs * acc[i][j][1] + b4.y);
                    pk.y = cvt_pk_bf16(rs * acc[i][j][2] + b4.z, rs * acc[i][j][3] + b4.w);
                    *(uint2*)(Cs + lrow * CS + wn * 64 + j * 16 + q4 * 4) = pk;
                }
            }
            __syncthreads();
#pragma unroll
            for (int it = 0; it < 8; ++it) {
                const int c = tid + 256 * it, row = c >> 4, cc = c & 15;
                *(u32x4*)(C + (size_t)(m0 + row) * ldc + n0 + cc * 8) = *(const u32x4*)(Cs + row * CS + cc * 8);
            }
        }
    }
}

DEVI void gdn_chunk_rows(int b, int dir, int np, int& row0, int& s0, int& L, int& seqbase) {
    if (np < 4) { const int tb = dir ? 3 - np : np; seqbase = NX + b * LC; s0 = tb * 64; L = LC; }
    else { const int tb = dir ? 31 - (np - 4) : (np - 4); seqbase = b * SEQ; s0 = tb * 64; L = SEQ; }
    row0 = seqbase + s0;
}
DEVI int kperm_pos(int k) { return ((k >> 5) << 5) + (((k >> 2) & 3) << 3) + (((k >> 4) & 1) << 2) + (k & 3); }

DEVI float wave_reduce16(const float (&s)[16], int lane) {
    float t8[8], t4[4], t2[2], tot;
#pragma unroll
    for (int i = 0; i < 8; ++i) { const float mine = (lane & 1) ? s[2 * i + 1] : s[2 * i], other = (lane & 1) ? s[2 * i] : s[2 * i + 1]; t8[i] = mine + xor_lane<1>(other); }
#pragma unroll
    for (int i = 0; i < 4; ++i) { const float mine = (lane & 2) ? t8[2 * i + 1] : t8[2 * i], other = (lane & 2) ? t8[2 * i] : t8[2 * i + 1]; t4[i] = mine + xor_lane<2>(other); }
#pragma unroll
    for (int i = 0; i < 2; ++i) { const float mine = (lane & 4) ? t4[2 * i + 1] : t4[2 * i], other = (lane & 4) ? t4[2 * i] : t4[2 * i + 1]; t2[i] = mine + xor_lane<4>(other); }
    { const float mine = (lane & 8) ? t2[1] : t2[0], other = (lane & 8) ? t2[0] : t2[1]; tot = mine + xor_lane<8>(other); }
    tot += xor_lane<16>(tot); tot += xor_lane<32>(tot);
    return tot;
}
DEVI float readlane_f(float v, int l) { return __uint_as_float((unsigned)__builtin_amdgcn_readlane((int)__float_as_uint(v), l)); }

DEVI void gdn_local_task(const Params& p, int l, int chain, int np, unsigned char* smem) {
    const int tid = tidx(), lane = tid & 63, wave = tid >> 6, r16 = lane & 15, g4 = lane >> 4;
    const int b = chain / 12, h = (chain % 12) >> 1, dir = chain & 1;
    int row0, s0, L, seqbase; gdn_chunk_rows(b, dir, np, row0, s0, L, seqbase);
    const bf16_t* P = (const bf16_t*)(p.ws + WS_P);
    unsigned char* chb = p.ws + WS_CH + ((size_t)chain * 36 + np) * CH_TASK_BYTES;
    bf16_t* qs = (bf16_t*)smem;
    bf16_t* ks = qs + 64 * 72;
    bf16_t* vs = ks + 64 * 72;
    float* Ld = (float*)(smem + 27648);
    bf16_t* als = (bf16_t*)(smem + 32768);
    float* Rm = (float*)(smem + 32768);
    float* gcs = (float*)(smem + 41984);
    float* betas = gcs + 64; float* egc = betas + 64; float* ekd = egc + 64;
    bf16_t* Lb = (bf16_t*)(smem + 43008);
    bf16_t* XT = (bf16_t*)(smem + 52224);
    bf16_t* raw = (bf16_t*)(smem + 43008);
    u32x4 rv[7];
#pragma unroll
    for (int it = 0; it < 7; ++it) {
        const int c = tid + 256 * it;
        rv[it] = (u32x4){0u, 0u, 0u, 0u};
        if (c < 3 * 68 * 8) {
            const int mat = c / 544, rem = c - mat * 544, rr = rem >> 3, c8 = rem & 7;
            const int s = s0 - 2 + rr;
            if (s >= 0 && s < L) rv[it] = *(const u32x4*)(P + (size_t)(seqbase + s) * INW + C_GQKV + mat * 384 + h * 64 + c8 * 8);
        }
    }
    __syncthreads();
    if (wave == 0) {
        const int ti = dir ? 63 - lane : lane;
        const bf16_t* pr = P + (size_t)(row0 + ti) * INW + C_GBA;
        const float braw = bf2f(pr[dir * 6 + h]), araw = bf2f(pr[12 + dir * 6 + h]);
        const float beta = sigmoid_f(braw);
        float gc = -__expf(sp_ptr(p, SP_ALOG)[l * 12 + dir * 6 + h]) * softplus_f(araw + sp_ptr(p, SP_DTB)[l * 12 + dir * 6 + h]);
#pragma unroll
        for (int off = 1; off < 64; off <<= 1) { const float t = __shfl_up(gc, off); if (lane >= off) gc += t; }
        const float gl = __shfl(gc, 63);
        gcs[lane] = gc; betas[lane] = beta; egc[lane] = __expf(gc); ekd[lane] = __expf(gl - gc);
        if (lane == 63) ((float*)(p.ws + WS_GL))[chain * 36 + np] = __expf(gc);
    }
#pragma unroll
    for (int it = 0; it < 7; ++it) {
        const int c = tid + 256 * it;
        if (c < 3 * 68 * 8) {
            const int mat = c / 544, rem = c - mat * 544, rr = rem >> 3, c8 = rem & 7;
            *(u32x4*)(raw + (mat * 68 + rr) * 64 + c8 * 8) = rv[it];
        }
    }
    __syncthreads();
    {
        const int d = lane, tq = wave;
        const float* cw = sp_ptr(p, SP_CONVW + l * 5 * 1152);
#pragma unroll 1
        for (int mat = 0; mat < 3; ++mat) {
            const int ch = mat * 384 + h * 64 + d;
            float w[5];
#pragma unroll
            for (int tap = 0; tap < 5; ++tap) w[tap] = cw[tap * 1152 + ch];
            float x[20];
#pragma unroll
            for (int tt = 0; tt < 20; ++tt) x[tt] = bf2f(raw[(mat * 68 + tq * 16 + tt) * 64 + d]);
            float y[16], sq[16];
#pragma unroll
            for (int t = 0; t < 16; ++t) {
                y[t] = silu_f(w[0] * x[t] + w[1] * x[t + 1] + w[2] * x[t + 2] + w[3] * x[t + 3] + w[4] * x[t + 4]);
                sq[t] = y[t] * y[t];
            }
            bf16_t* dst = (mat == 0) ? qs : ((mat == 1) ? ks : vs);
            float rsn = 1.f;
            if (mat < 2) rsn = rsqrtf(wave_reduce16(sq, lane) + 1e-6f);
#pragma unroll
            for (int t = 0; t < 16; ++t) {
                const float f = (mat < 2) ? readlane_f(rsn, t) : 1.f;
                const int tok = tq * 16 + t, i = dir ? 63 - tok : tok;
                dst[i * 72 + d] = f2bf(y[t] * f);
            }
        }
    }
    __syncthreads();
    for (int i = tid; i < 18432 / 16; i += NT) ((u32x4*)XT)[i] = (u32x4){0u, 0u, 0u, 0u};
    {
        bf16x8 ak[2], aq[2];
#pragma unroll
        for (int kk = 0; kk < 2; ++kk) {
            ak[kk] = *(const bf16x8*)(ks + (wave * 16 + r16) * 72 + kk * 32 + g4 * 8);
            aq[kk] = *(const bf16x8*)(qs + (wave * 16 + r16) * 72 + kk * 32 + g4 * 8);
        }
        const int wave_u = __builtin_amdgcn_readfirstlane(wave);
        float gci[4], bti[4];
#pragma unroll
        for (int r = 0; r < 4; ++r) { gci[r] = gcs[wave * 16 + g4 * 4 + r]; bti[r] = betas[wave * 16 + g4 * 4 + r]; }
#pragma unroll
        for (int tj = 0; tj < 4; ++tj) {
            if (tj > wave_u) {
                const int zr = wave * 16 + (lane >> 2), zc = tj * 16 + (lane & 3) * 4;
                *(uint2*)(Lb + zr * 72 + zc) = make_uint2(0u, 0u);
                *(uint2*)(als + zr * 72 + zc) = make_uint2(0u, 0u);
                continue;
            }
            f32x4 ckk = (f32x4){0.f, 0.f, 0.f, 0.f}, cqk = (f32x4){0.f, 0.f, 0.f, 0.f};
#pragma unroll
            for (int kk = 0; kk < 2; ++kk) {
                const bf16x8 bk = *(const bf16x8*)(ks + (tj * 16 + r16) * 72 + kk * 32 + g4 * 8);
                ckk = __builtin_amdgcn_mfma_f32_16x16x32_bf16(ak[kk], bk, ckk, 0, 0, 0);
                cqk = __builtin_amdgcn_mfma_f32_16x16x32_bf16(aq[kk], bk, cqk, 0, 0, 0);
            }
            const int j = tj * 16 + r16;
            const float gcj = gcs[j];
            if (tj == wave_u) {
#pragma unroll
                for (int r = 0; r < 4; ++r) {
                    const int i = wave * 16 + g4 * 4 + r;
                    const float dec = __expf((j <= i) ? (gci[r] - gcj) : 0.f);
                    const float lv = (j < i) ? bti[r] * ckk[r] * dec : 0.f;
                    Lb[i * 72 + j] = f2bf(lv);
                    Ld[(wave * 16 + g4 * 4 + r) * 20 + r16] = lv;
                    als[i * 72 + j] = f2bf((j <= i) ? cqk[r] * 0.125f * dec : 0.f);
                }
            } else {
#pragma unroll
                for (int r = 0; r < 4; ++r) {
                    const int i = wave * 16 + g4 * 4 + r;
                    const float dec = __expf(gci[r] - gcj);
                    Lb[i * 72 + j] = f2bf(bti[r] * ckk[r] * dec);
                    als[i * 72 + j] = f2bf(cqk[r] * 0.125f * dec);
                }
            }
        }
    }
    __syncthreads();
    {
#pragma unroll
        for (int it = 0; it < 2; ++it) {
            const int cc = tid + 256 * it, m = cc >> 3, kc = cc & 7, kss = kc >> 2, gg = kc & 3;
            const int k0 = kss * 32 + gg * 4, k1 = k0 + 16;
            {
                const uint2 a = *(const uint2*)(als + m * 72 + k0), bq = *(const uint2*)(als + m * 72 + k1);
                u32x4 o; o.x = a.x; o.y = a.y; o.z = bq.x; o.w = bq.y;
                *(u32x4*)(chb + 2 * 8192 + cc * 16) = o;
            }
            {
                const float sc = 0.125f * egc[m];
                const uint2 a = *(const uint2*)(qs + m * 72 + k0), bq = *(const uint2*)(qs + m * 72 + k1);
                u32x4 o;
                o.x = cvt_pk_bf16(lo_f(a.x) * sc, hi_f(a.x) * sc); o.y = cvt_pk_bf16(lo_f(a.y) * sc, hi_f(a.y) * sc);
                o.z = cvt_pk_bf16(lo_f(bq.x) * sc, hi_f(bq.x) * sc); o.w = cvt_pk_bf16(lo_f(bq.y) * sc, hi_f(bq.y) * sc);
                *(u32x4*)(chb + 1 * 8192 + cc * 16) = o;
            }
            {
                float v[8];
#pragma unroll
                for (int jj = 0; jj < 4; ++jj) { v[jj] = bf2f(ks[(k0 + jj) * 72 + m]) * ekd[k0 + jj]; v[4 + jj] = bf2f(ks[(k1 + jj) * 72 + m]) * ekd[k1 + jj]; }
                u32x4 o; o.x = cvt_pk_bf16(v[0], v[1]); o.y = cvt_pk_bf16(v[2], v[3]); o.z = cvt_pk_bf16(v[4], v[5]); o.w = cvt_pk_bf16(v[6], v[7]);
                *(u32x4*)(chb + 3 * 8192 + cc * 16) = o;
            }
        }
    }
    {
        float lrow[16];
        {
            const f32x4* lp = (const f32x4*)(Ld + (wave * 16 + (lane & 15)) * 20);
#pragma unroll
            for (int q = 0; q < 4; ++q) { const f32x4 v = lp[q]; lrow[4 * q] = v.x; lrow[4 * q + 1] = v.y; lrow[4 * q + 2] = v.z; lrow[4 * q + 3] = v.w; }
        }
        const int c = lane & 15;
        float x[16];
#pragma unroll
        for (int ii = 0; ii < 16; ++ii) {
            float a0 = (ii == c) ? 1.f : 0.f, a1 = 0.f;
#pragma unroll
            for (int jj = 0; jj < ii; ++jj) { const float lv = readlane_f(lrow[jj], ii); if (jj & 1) a1 -= lv * x[jj]; else a0 -= lv * x[jj]; }
            x[ii] = a0 + a1;
        }
        __builtin_amdgcn_wave_barrier();
        if (lane < 16) {
#pragma unroll
            for (int ii = 0; ii < 16; ++ii) Ld[(wave * 16 + ii) * 20 + c] = x[ii];
        }
    }
    __syncthreads();
#pragma unroll 1
    for (int bb = 0; bb < 4; ++bb) {
#pragma unroll
        for (int q = 0; q < 2; ++q) {
            const int nt = wave * 2 + q;
            f32x4 acc = (f32x4){0.f, 0.f, 0.f, 0.f};
            if (bb > 0) {
                const bf16x8 a0 = *(const bf16x8*)(Lb + (bb * 16 + r16) * 72 + g4 * 8);
                const bf16x8 b0 = *(const bf16x8*)(XT + (nt * 16 + r16) * 72 + g4 * 8);
                acc = __builtin_amdgcn_mfma_f32_16x16x32_bf16(a0, b0, acc, 0, 0, 0);
                if (bb == 3) {
                    const bf16x8 a1 = *(const bf16x8*)(Lb + (bb * 16 + r16) * 72 + 32 + g4 * 8);
                    const bf16x8 b1 = *(const bf16x8*)(XT + (nt * 16 + r16) * 72 + 32 + g4 * 8);
                    acc = __builtin_amdgcn_mfma_f32_16x16x32_bf16(a1, b1, acc, 0, 0, 0);
                }
            }
            const bool isw = nt >= 4;
            const bf16_t* src = isw ? ks : vs;
            const int cc = (nt & 3) * 16 + r16;
            float rh[4], nv[4];
#pragma unroll
            for (int kb = 0; kb < 4; ++kb) {
                const int i = bb * 16 + 4 * g4 + kb;
                float v = bf2f(src[i * 72 + cc]) * betas[i];
                if (isw) v *= egc[i];
                rh[kb] = v - acc[kb];
                nv[kb] = Ld[(bb * 16 + r16) * 20 + 4 * g4 + kb];
            }
            f32x4 xa = (f32x4){0.f, 0.f, 0.f, 0.f};
#pragma unroll
            for (int kb = 0; kb < 4; ++kb) xa = __builtin_amdgcn_mfma_f32_16x16x4f32(rh[kb], nv[kb], xa, 0, 0, 0);
#pragma unroll
            for (int r = 0; r < 4; ++r) XT[(nt * 16 + 4 * g4 + r) * 72 + bb * 16 + r16] = f2bf(xa[r]);
        }
    }
    __syncthreads();
    {
#pragma unroll
        for (int it = 0; it < 2; ++it) {
            const int cc = tid + 256 * it, m = cc >> 3, kc = cc & 7, kss = kc >> 2, gg = kc & 3;
            const int k0 = kss * 32 + gg * 4, k1 = k0 + 16;
            *(u32x4*)(chb + 4 * 8192 + cc * 16) = *(const u32x4*)(XT + m * 72 + kc * 8);
            float v[8];
#pragma unroll
            for (int jj = 0; jj < 4; ++jj) { v[jj] = -bf2f(XT[(64 + k0 + jj) * 72 + m]); v[4 + jj] = -bf2f(XT[(64 + k1 + jj) * 72 + m]); }
            u32x4 o; o.x = cvt_pk_bf16(v[0], v[1]); o.y = cvt_pk_bf16(v[2], v[3]); o.z = cvt_pk_bf16(v[4], v[5]); o.w = cvt_pk_bf16(v[6], v[7]);
            *(u32x4*)(chb + 0 * 8192 + cc * 16) = o;
        }
    }
}

DEVI void pool_task(const Params& p, int l, int t0row, unsigned char* smem) {
    const int tid = tidx();
    float* a = (float*)smem;
    const bf16_t* P = (const bf16_t*)(p.ws + WS_P);
    bf16_t* Y = (bf16_t*)(p.ws + WS_Y);
    int s0, L, base;
    if (t0row < NX) { s0 = t0row & 2047; L = SEQ; base = t0row - s0; } else { s0 = (t0row - NX) & 255; L = LC; base = t0row - s0; }
    bf16x8 wf[4][2];
    {
        const int lane = tid & 63, gi = tid >> 6, r16 = lane & 15, g4 = lane >> 4;
        const bf16_t* wt = (const bf16_t*)sp_ptr(p, SP_WPOOL) + (size_t)((l * 4 + gi) * 64) * 64;
#pragma unroll
        for (int nt = 0; nt < 4; ++nt)
#pragma unroll
            for (int ks = 0; ks < 2; ++ks) wf[nt][ks] = *(const bf16x8*)(wt + (nt * 16 + r16) * 64 + ks * 32 + g4 * 8);
    }
    __syncthreads();
#pragma unroll
    for (int it = 0; it < 4; ++it) {
        const int c = tid + 256 * it, rr = c >> 5, cc = (c & 31) * 8;
        const int s = s0 - 8 + rr;
        uint4 v = make_uint4(0u, 0u, 0u, 0u);
        if (s >= 0 && s < L) v = *(const uint4*)(P + (size_t)(base + s) * INW + C_POOL + cc);
        float* dst = a + rr * 256 + cc;
        dst[0] = lo_f(v.x); dst[1] = hi_f(v.x); dst[2] = lo_f(v.y); dst[3] = hi_f(v.y);
        dst[4] = lo_f(v.z); dst[5] = hi_f(v.z); dst[6] = lo_f(v.w); dst[7] = hi_f(v.w);
    }
    __syncthreads();
    bf16_t* Pb = (bf16_t*)(smem + 32768);
    bf16_t* Ys = Pb + 16 * 264;
    {
        const int ch = tid, gi = ch >> 6, hw = 1 << gi;
        float sum = 0.f;
#pragma unroll
        for (int k = -8; k < 8; ++k) { const float v = a[(8 + k) * 256 + ch]; sum += (k >= -hw && k < hw) ? v : 0.f; }
        const float* ain = a + (8 + hw) * 256 + ch;
        const float* aout = a + (8 - hw) * 256 + ch;
#pragma unroll
        for (int tok = 0; tok < 16; ++tok) {
            const int s = s0 + tok;
            int lo = s - hw; if (lo < 0) lo = 0;
            int hi = s + hw; if (hi > L) hi = L;
            Pb[tok * 264 + ch] = f2bf(sum * __builtin_amdgcn_rcpf((float)(hi - lo)) - a[(tok + 8) * 256 + ch]);
            sum += ain[tok * 256] - aout[tok * 256];
        }
    }
    __syncthreads();
    {
        const int lane = tid & 63, gi = tid >> 6, r16 = lane & 15, g4 = lane >> 4;
        bf16x8 af[2];
#pragma unroll
        for (int ks = 0; ks < 2; ++ks) af[ks] = *(const bf16x8*)(Pb + r16 * 264 + gi * 64 + ks * 32 + g4 * 8);
        const float* ps = sp_ptr(p, SP_PSCALE) + l * 256 + gi * 64;
#pragma unroll
        for (int nt = 0; nt < 4; ++nt) {
            f32x4 acc = (f32x4){0.f, 0.f, 0.f, 0.f};
#pragma unroll
            for (int ks = 0; ks < 2; ++ks) acc = __builtin_amdgcn_mfma_f32_16x16x32_bf16(af[ks], wf[nt][ks], acc, 0, 0, 0);
            const float sc = ps[nt * 16 + r16];
#pragma unroll
            for (int r = 0; r < 4; ++r) Ys[(g4 * 4 + r) * 264 + gi * 64 + nt * 16 + r16] = f2bf(acc[r] * sc);
        }
    }
    __syncthreads();
#pragma unroll
    for (int it = 0; it < 2; ++it) {
        const int c = tid + 256 * it, tok = c >> 5, cc = c & 31;
        *(u32x4*)(Y + (size_t)(t0row + tok) * D + cc * 8) = *(const u32x4*)(Ys + tok * 264 + cc * 8);
    }
}

DEVI void attn_task(const Params& p, int l, int qrow0, int qh, bool is_x, int b, int n, unsigned char* smem) {
    const int tid = tidx(), lane = tid & 63, wave = tid >> 6, r16 = lane & 15, g4 = lane >> 4;
    const bf16_t* P = (const bf16_t*)(p.ws + WS_P);
    bf16_t* Y = (bf16_t*)(p.ws + WS_Y);
    const float* rc = (const float*)(p.ws + WS_ROPE); const float* rsn = rc + 2048 * 32;
    bf16_t* Ksm = (bf16_t*)smem;
    bf16_t* Vt = Ksm + 64 * 72;
    const int hk = qh / 3;
    bf16x8 qf[2][2];
#pragma unroll
    for (int mt = 0; mt < 2; ++mt) {
        const int row = qrow0 + wave * 32 + mt * 16 + r16;
#pragma unroll
        for (int ks = 0; ks < 2; ++ks) {
            const u32x4 raw = *(const u32x4*)(P + (size_t)row * INW + C_AQ + qh * 64 + ks * 32 + g4 * 8);
            float x[8] = {lo_f(raw.x), hi_f(raw.x), lo_f(raw.y), hi_f(raw.y), lo_f(raw.z), hi_f(raw.z), lo_f(raw.w), hi_f(raw.w)};
            if (is_x) {
                const int s = row & 2047;
                const u32x4 raw2 = *(const u32x4*)(P + (size_t)row * INW + C_AQ + qh * 64 + ks * 32 + (g4 ^ 2) * 8);
                const float x2v[8] = {lo_f(raw2.x), hi_f(raw2.x), lo_f(raw2.y), hi_f(raw2.y), lo_f(raw2.z), hi_f(raw2.z), lo_f(raw2.w), hi_f(raw2.w)};
                const float4* c4 = (const float4*)(rc + s * 32 + ks * 16 + (g4 & 1) * 8);
                const float4* s4 = (const float4*)(rsn + s * 32 + ks * 16 + (g4 & 1) * 8);
                const float4 ca = c4[0], cb = c4[1], sa4 = s4[0], sb4 = s4[1];
                const float cv[8] = {ca.x, ca.y, ca.z, ca.w, cb.x, cb.y, cb.z, cb.w};
                const float sv[8] = {sa4.x, sa4.y, sa4.z, sa4.w, sb4.x, sb4.y, sb4.z, sb4.w};
#pragma unroll
                for (int j = 0; j < 8; ++j) {
                    const float other = x2v[j];
                    x[j] = (g4 < 2) ? (x[j] * cv[j] - other * sv[j]) : (x[j] * cv[j] + other * sv[j]);
                }
            }
            u32x4 pk;
            constexpr float QS = 0.125f * 1.4426950408889634f;
            pk.x = cvt_pk_bf16(x[0] * QS, x[1] * QS); pk.y = cvt_pk_bf16(x[2] * QS, x[3] * QS);
            pk.z = cvt_pk_bf16(x[4] * QS, x[5] * QS); pk.w = cvt_pk_bf16(x[6] * QS, x[7] * QS);
            qf[mt][ks] = __builtin_bit_cast(bf16x8, pk);
        }
    }
    f32x4 O[2][4];
#pragma unroll
    for (int mt = 0; mt < 2; ++mt)
#pragma unroll
        for (int dt = 0; dt < 4; ++dt) O[mt][dt] = (f32x4){0.f, 0.f, 0.f, 0.f};
    const float sinkv = sp_ptr(p, SP_SINK)[l * 6 + qh] * 1.4426950408889634f;
    float mrow[2] = {sinkv, sinkv};
    float lpart[2] = {g4 == 0 ? 1.f : 0.f, g4 == 0 ? 1.f : 0.f};
    for (int sg = (is_x ? 0 : 3); sg < 5; ++sg) {
        if (sg == 0 && n == 0) continue;
        if (sg == 2 && n == 15) continue;
        const int krow0 = (sg < 3) ? (b * SEQ + (n - 1 + sg) * 128) : (NX + b * LC + (sg - 3) * 128);
        const int mtype = (sg < 3) ? 1 : 0;
        const int krope = (sg < 3) ? 1 : 0;
        for (int sub = 0; sub < 2; ++sub) {
            __syncthreads();
            {
                const int key = tid >> 2, a = (tid >> 1) & 1, ph = tid & 1;
                const int krow = krow0 + sub * 64 + key;
                const bf16_t* kp = P + (size_t)krow * INW + C_AK + hk * 64 + a * 32 + ph * 8;
                const bf16_t* vp = P + (size_t)krow * INW + C_AV + hk * 64 + a * 32 + ph * 8;
                const u32x4 k1 = *(const u32x4*)kp, k2 = *(const u32x4*)(kp + 16);
                const u32x4 v1 = *(const u32x4*)vp, v2 = *(const u32x4*)(vp + 16);
                float x1[8] = {lo_f(k1.x), hi_f(k1.x), lo_f(k1.y), hi_f(k1.y), lo_f(k1.z), hi_f(k1.z), lo_f(k1.w), hi_f(k1.w)};
                float x2[8] = {lo_f(k2.x), hi_f(k2.x), lo_f(k2.y), hi_f(k2.y), lo_f(k2.z), hi_f(k2.z), lo_f(k2.w), hi_f(k2.w)};
                if (krope) {
                    const int s = krow & 2047;
                    const float4* c4 = (const float4*)(rc + s * 32 + a * 16 + ph * 8);
                    const float4* s4 = (const float4*)(rsn + s * 32 + a * 16 + ph * 8);
                    const float4 ca = c4[0], cb = c4[1], sa4 = s4[0], sb4 = s4[1];
                    const float cv[8] = {ca.x, ca.y, ca.z, ca.w, cb.x, cb.y, cb.z, cb.w};
                    const float sv[8] = {sa4.x, sa4.y, sa4.z, sa4.w, sb4.x, sb4.y, sb4.z, sb4.w};
#pragma unroll
                    for (int j = 0; j < 8; ++j) {
                        const float y1 = x1[j] * cv[j] - x2[j] * sv[j], y2 = x2[j] * cv[j] + x1[j] * sv[j];
                        x1[j] = y1; x2[j] = y2;
                    }
                }
                u32x4 o1, o2;
                o1.x = cvt_pk_bf16(x1[0], x1[1]); o1.y = cvt_pk_bf16(x1[2], x1[3]); o1.z = cvt_pk_bf16(x1[4], x1[5]); o1.w = cvt_pk_bf16(x1[6], x1[7]);
                o2.x = cvt_pk_bf16(x2[0], x2[1]); o2.y = cvt_pk_bf16(x2[2], x2[3]); o2.z = cvt_pk_bf16(x2[4], x2[5]); o2.w = cvt_pk_bf16(x2[6], x2[7]);
                *(u32x4*)(Ksm + key * 72 + a * 32 + ph * 8) = o1;
                *(u32x4*)(Ksm + key * 72 + a * 32 + 16 + ph * 8) = o2;
                const int kp2 = kperm_pos(key);
                const unsigned vv[8] = {v1.x, v1.y, v1.z, v1.w, v2.x, v2.y, v2.z, v2.w};
#pragma unroll
                for (int j = 0; j < 4; ++j) {
                    const int d0 = a * 32 + ph * 8 + 2 * j;
                    Vt[(d0) * 72 + kp2] = (bf16_t)(vv[j] & 0xffffu);
                    Vt[(d0 + 1) * 72 + kp2] = (bf16_t)(vv[j] >> 16);
                    Vt[(d0 + 16) * 72 + kp2] = (bf16_t)(vv[4 + j] & 0xffffu);
                    Vt[(d0 + 17) * 72 + kp2] = (bf16_t)(vv[4 + j] >> 16);
                }
            }
            __syncthreads();
            bf16x8 kf[4][2];
#pragma unroll
            for (int kt = 0; kt < 4; ++kt)
#pragma unroll
                for (int ks = 0; ks < 2; ++ks) kf[kt][ks] = *(const bf16x8*)(Ksm + (kt * 16 + r16) * 72 + ks * 32 + g4 * 8);
#pragma unroll
            for (int mt = 0; mt < 2; ++mt) {
                f32x4 st[4];
#pragma unroll
                for (int kt = 0; kt < 4; ++kt) {
                    st[kt] = (f32x4){0.f, 0.f, 0.f, 0.f};
#pragma unroll
                    for (int ks = 0; ks < 2; ++ks) st[kt] = __builtin_amdgcn_mfma_f32_16x16x32_bf16(kf[kt][ks], qf[mt][ks], st[kt], 0, 0, 0);
                }
                const int qi = wave * 32 + mt * 16 + r16;
                float mx = mrow[mt];
                if (sg == 0 || sg == 2) {
#pragma unroll
                    for (int kt = 0; kt < 4; ++kt)
#pragma unroll
                        for (int r = 0; r < 4; ++r) {
                            const int kpos = krow0 + sub * 64 + kt * 16 + g4 * 4 + r;
                            const int dpos = kpos - (qrow0 + qi);
                            const bool valid = (dpos <= 128 && dpos >= -128);
                            st[kt][r] = valid ? st[kt][r] : -1e30f;
                        }
                }
#pragma unroll
                for (int kt = 0; kt < 4; ++kt)
#pragma unroll
                    for (int r = 0; r < 4; ++r) mx = fmaxf(mx, st[kt][r]);
                mx = fmaxf(mx, xor_lane<16>(mx)); mx = fmaxf(mx, xor_lane<32>(mx));
                const float alpha = __builtin_amdgcn_exp2f(mrow[mt] - mx);
                mrow[mt] = mx;
                float psum = 0.f;
#pragma unroll
                for (int kt = 0; kt < 4; ++kt)
#pragma unroll
                    for (int r = 0; r < 4; ++r) { st[kt][r] = __builtin_amdgcn_exp2f(st[kt][r] - mx); psum += st[kt][r]; }
                lpart[mt] = lpart[mt] * alpha + psum;
                bf16x8 pf[2];
#pragma unroll
                for (int ks = 0; ks < 2; ++ks) {
                    u32x4 pk;
                    pk.x = cvt_pk_bf16(st[2 * ks][0], st[2 * ks][1]); pk.y = cvt_pk_bf16(st[2 * ks][2], st[2 * ks][3]);
                    pk.z = cvt_pk_bf16(st[2 * ks + 1][0], st[2 * ks + 1][1]); pk.w = cvt_pk_bf16(st[2 * ks + 1][2], st[2 * ks + 1][3]);
                    pf[ks] = __builtin_bit_cast(bf16x8, pk);
                }
#pragma unroll
                for (int dt = 0; dt < 4; ++dt) {
                    f32x4 o = O[mt][dt] * alpha;
#pragma unroll
                    for (int ks = 0; ks < 2; ++ks) {
                        const bf16x8 vf = *(const bf16x8*)(Vt + (dt * 16 + r16) * 72 + ks * 32 + g4 * 8);
                        o = __builtin_amdgcn_mfma_f32_16x16x32_bf16(vf, pf[ks], o, 0, 0, 0);
                    }
                    O[mt][dt] = o;
                }
            }
        }
    }
#pragma unroll
    for (int mt = 0; mt < 2; ++mt) {
        float lt = lpart[mt];
        lt += xor_lane<16>(lt); lt += xor_lane<32>(lt);
        const float inv = __builtin_amdgcn_rcpf(lt);
        const int row = qrow0 + wave * 32 + mt * 16 + r16;
#pragma unroll
        for (int dt = 0; dt < 4; ++dt) {
            uint2 pk;
            pk.x = cvt_pk_bf16(O[mt][dt][0] * inv, O[mt][dt][1] * inv); pk.y = cvt_pk_bf16(O[mt][dt][2] * inv, O[mt][dt][3] * inv);
            *(uint2*)(Y + (size_t)row * D + 640 + qh * 64 + dt * 16 + g4 * 4) = pk;
        }
    }
}

DEVI void mix_task(const Params& p, int l, int u, int n_pool, unsigned char* smem) {
    const int n_attx = NB * 16 * 6;
    if (u < n_pool) { pool_task(p, l, u * 16, smem); return; }
    u -= n_pool;
    if (u < n_attx) { const int b = u / 96, n = (u % 96) / 6, qh = u % 6; attn_task(p, l, b * SEQ + n * 128, qh, true, b, n, smem); return; }
    u -= n_attx;
    { const int b = u / 12, qb = (u % 12) / 6, qh = u % 6; attn_task(p, l, NX + b * LC + qb * 128, qh, false, b, 1, smem); }
}
DEVI void phase_mix1(const Params& p, int l, unsigned char* smem) {
    for (int t = blockIdx.x; t < 96 * 36; t += gridDim.x) gdn_local_task(p, l, t / 36, t % 36, smem);
}

DEVI void phase_gdn_scan_chains(const Params& p, unsigned char* smem) {
    const int tid = tidx(), lane = tid & 63, wave = tid >> 6, r16 = lane & 15, g4 = lane >> 4;
    bf16_t* GO = (bf16_t*)(p.ws + WS_GO);
    const float* GL = (const float*)(p.ws + WS_GL);
    for (int chain = blockIdx.x; chain < 96; chain += gridDim.x) {
        const int b = chain / 12, h = (chain % 12) >> 1, dir = chain & 1;
        const unsigned char* chain_base = p.ws + WS_CH + (size_t)chain * 36 * CH_TASK_BYTES;
        f32x4 S[4];
#pragma unroll
        for (int t = 0; t < 4; ++t) S[t] = (f32x4){0.f, 0.f, 0.f, 0.f};
        const float glv = GL[chain * 36 + (lane < 36 ? lane : 35)];
        u32x4 pre[8]; uint2 upre[4];
#pragma unroll
        for (int i = 0; i < 8; ++i) pre[i] = *(const u32x4*)(chain_base + (size_t)(tid + 256 * i) * 16);
#pragma unroll
        for (int t = 0; t < 4; ++t) upre[t] = *(const uint2*)(chain_base + 4 * 8192 + ((wave * 16 + r16) * 64 + t * 16 + g4 * 4) * 2);
        bf16_t* Os = (bf16_t*)(smem + 36864);
#define SCAN_FLUSH(npf) do { int row0f, s0f, Lf, sbf; gdn_chunk_rows(b, dir, (npf), row0f, s0f, Lf, sbf); \
            _Pragma("unroll") for (int i = 0; i < 2; ++i) { const int c = (tid >> 3) + 32 * i, ti = dir ? 63 - c : c; \
                *(u32x4*)(GO + ((size_t)dir * NTOK + row0f + ti) * 384 + h * 64 + (tid & 7) * 8) = *(const u32x4*)(Os + c * 72 + (tid & 7) * 8); } } while (0)
        for (int np = 0; np < 36; ++np) {
            __syncthreads();
            if (np > 0) SCAN_FLUSH(np - 1);
#pragma unroll
            for (int i = 0; i < 8; ++i) {
                const int c = tid + 256 * i, mat = c >> 9, cc = c & 511, row = cc >> 3, kc = cc & 7;
                *(u32x4*)(smem + mat * 9216 + row * 144 + kc * 16) = pre[i];
            }
            uint2 ucur[4];
#pragma unroll
            for (int t = 0; t < 4; ++t) ucur[t] = upre[t];
            __syncthreads();
            {
                const int nn = (np + 1 < 36) ? np + 1 : np;
                const unsigned char* nb = chain_base + (size_t)nn * CH_TASK_BYTES;
#pragma unroll
                for (int i = 0; i < 8; ++i) pre[i] = *(const u32x4*)(nb + (size_t)(tid + 256 * i) * 16);
#pragma unroll
                for (int t = 0; t < 4; ++t) upre[t] = *(const uint2*)(nb + 4 * 8192 + ((wave * 16 + r16) * 64 + t * 16 + g4 * 4) * 2);
            }
            const float gl = readlane_f(glv, np);
            bf16x8 sb[2];
#pragma unroll
            for (int kk = 0; kk < 2; ++kk) {
                u32x4 pk;
                pk.x = cvt_pk_bf16(S[2 * kk][0], S[2 * kk][1]); pk.y = cvt_pk_bf16(S[2 * kk][2], S[2 * kk][3]);
                pk.z = cvt_pk_bf16(S[2 * kk + 1][0], S[2 * kk + 1][1]); pk.w = cvt_pk_bf16(S[2 * kk + 1][2], S[2 * kk + 1][3]);
                sb[kk] = __builtin_bit_cast(bf16x8, pk);
            }
            bf16x8 aw[4][2], aq[4][2], aa[4][2], ak[4][2];
#pragma unroll
            for (int t = 0; t < 4; ++t)
#pragma unroll
                for (int kk = 0; kk < 2; ++kk) aw[t][kk] = *(const bf16x8*)(smem + 0 * 9216 + (t * 16 + r16) * 144 + kk * 64 + g4 * 16);
#pragma unroll
            for (int t = 0; t < 4; ++t)
#pragma unroll
                for (int kk = 0; kk < 2; ++kk) aq[t][kk] = *(const bf16x8*)(smem + 1 * 9216 + (t * 16 + r16) * 144 + kk * 64 + g4 * 16);
            __builtin_amdgcn_sched_barrier(0);
            f32x4 VN[4];
#pragma unroll
            for (int t = 0; t < 4; ++t) VN[t] = (f32x4){lo_f(ucur[t].x), hi_f(ucur[t].x), lo_f(ucur[t].y), hi_f(ucur[t].y)};
#pragma unroll
            for (int kk = 0; kk < 2; ++kk)
#pragma unroll
                for (int t = 0; t < 4; ++t) VN[t] = __builtin_amdgcn_mfma_f32_16x16x32_bf16(aw[t][kk], sb[kk], VN[t], 0, 0, 0);
            __builtin_amdgcn_sched_barrier(0);
#pragma unroll
            for (int t = 0; t < 4; ++t)
#pragma unroll
                for (int kk = 0; kk < 2; ++kk) ak[t][kk] = *(const bf16x8*)(smem + 3 * 9216 + (t * 16 + r16) * 144 + kk * 64 + g4 * 16);
            f32x4 O[4];
#pragma unroll
            for (int t = 0; t < 4; ++t) O[t] = (f32x4){0.f, 0.f, 0.f, 0.f};
#pragma unroll
            for (int kk = 0; kk < 2; ++kk)
#pragma unroll
                for (int t = 0; t < 4; ++t) O[t] = __builtin_amdgcn_mfma_f32_16x16x32_bf16(aq[t][kk], sb[kk], O[t], 0, 0, 0);
            __builtin_amdgcn_sched_barrier(0);
#pragma unroll
            for (int t = 0; t < 4; ++t)
#pragma unroll
                for (int kk = 0; kk < 2; ++kk) aa[t][kk] = *(const bf16x8*)(smem + 2 * 9216 + (t * 16 + r16) * 144 + kk * 64 + g4 * 16);
            bf16x8 vb[2];
#pragma unroll
            for (int kk = 0; kk < 2; ++kk) {
                u32x4 pk;
                pk.x = cvt_pk_bf16(VN[2 * kk][0], VN[2 * kk][1]); pk.y = cvt_pk_bf16(VN[2 * kk][2], VN[2 * kk][3]);
                pk.z = cvt_pk_bf16(VN[2 * kk + 1][0], VN[2 * kk + 1][1]); pk.w = cvt_pk_bf16(VN[2 * kk + 1][2], VN[2 * kk + 1][3]);
                vb[kk] = __builtin_bit_cast(bf16x8, pk);
            }
            f32x4 sn[4];
#pragma unroll
            for (int t = 0; t < 4; ++t) sn[t] = S[t] * gl;
#pragma unroll
            for (int kk = 0; kk < 2; ++kk)
#pragma unroll
                for (int t = 0; t < 4; ++t) sn[t] = __builtin_amdgcn_mfma_f32_16x16x32_bf16(ak[t][kk], vb[kk], sn[t], 0, 0, 0);
#pragma unroll
            for (int kk = 0; kk < 2; ++kk)
#pragma unroll
                for (int t = 0; t < 4; ++t) O[t] = __builtin_amdgcn_mfma_f32_16x16x32_bf16(aa[t][kk], vb[kk], O[t], 0, 0, 0);
#pragma unroll
            for (int t = 0; t < 4; ++t) S[t] = sn[t];
            __builtin_amdgcn_sched_barrier(0);
#pragma unroll
            for (int t = 0; t < 4; ++t)
#pragma unroll
                for (int r = 0; r < 4; ++r) Os[(t * 16 + g4 * 4 + r) * 72 + wave * 16 + r16] = f2bf(O[t][r]);
        }
        __syncthreads();
        SCAN_FLUSH(35);
#undef SCAN_FLUSH
    }
}

DEVI void phase_gdn_scan(const Params& p, int l, unsigned char* smem) {
    phase_gdn_scan_chains(p, smem);
    const bool need_ctx = (l == 0);
    const int n_pool = (need_ctx ? NTOK : NX) / 16, n_att = NB * 16 * 6 + (need_ctx ? NB * 2 * 6 : 0);
    const int total = n_pool + n_att;
    unsigned* qhead = (unsigned*)(p.ws + WS_BAR) + 3600 + l;
    volatile unsigned* slot = (volatile unsigned*)(smem + SMEM_BYTES + 8);
    for (;;) {
        __syncthreads();
        if (threadIdx.x == 0) *slot = __hip_atomic_fetch_add(qhead, 1u, __ATOMIC_RELAXED, __HIP_MEMORY_SCOPE_AGENT);
        __syncthreads();
        const int q = (int)*slot;
        if (q >= total) break;
        const int u = (q < n_att) ? (n_pool + q) : (q - n_att);
        mix_task(p, l, u, n_pool, smem);
    }
}

DEVI void phase_gdn_finish(const Params& p, int l, int nrows) {
    const int lane = tidx() & 63, wave = tidx() >> 6;
    const bf16_t* GO = (const bf16_t*)(p.ws + WS_GO);
    const bf16_t* P = (const bf16_t*)(p.ws + WS_P);
    bf16_t* Y = (bf16_t*)(p.ws + WS_Y);
    const float4 gn = *(const float4*)(sp_ptr(p, SP_GDNN) + l * 64 + (lane & 15) * 4);
    for (int r = blockIdx.x * 4 + wave; r < nrows; r += gridDim.x * 4) {
#pragma unroll
        for (int ps = 0; ps < 2; ++ps) {
            const int ch = ps * 256 + lane * 4;
            if (ch < 384) {
                const uint2 a = *(const uint2*)(GO + (size_t)r * 384 + ch), b = *(const uint2*)(GO + ((size_t)NTOK + r) * 384 + ch);
                const uint2 zz = *(const uint2*)(P + (size_t)r * INW + C_GZ + ch);
                const float o0 = lo_f(a.x) + lo_f(b.x), o1 = hi_f(a.x) + hi_f(b.x), o2 = lo_f(a.y) + lo_f(b.y), o3 = hi_f(a.y) + hi_f(b.y);
                float ss = o0 * o0 + o1 * o1 + o2 * o2 + o3 * o3;
                ss += xor_lane<1>(ss); ss += xor_lane<2>(ss); ss += xor_lane<4>(ss); ss += xor_lane<8>(ss);
                const float rs = rsqrtf(ss * (1.f / 64.f) + 1e-6f);
                uint2 y;
                y.x = cvt_pk_bf16(o0 * rs * gn.x * silu_f(lo_f(zz.x)), o1 * rs * gn.y * silu_f(hi_f(zz.x)));
                y.y = cvt_pk_bf16(o2 * rs * gn.z * silu_f(lo_f(zz.y)), o3 * rs * gn.w * silu_f(hi_f(zz.y)));
                *(uint2*)(Y + (size_t)r * D + 256 + ch) = y;
            }
        }
    }
}

DEVI void cmpx(float& a, float& b) { const float t = fmaxf(a, b); b = fminf(a, b); a = t; }
template <int N> DEVI void bitonic_sort_desc(float (&v)[N]) {
#pragma unroll
    for (int k = 2; k <= N; k <<= 1) {
#pragma unroll
        for (int j = k >> 1; j > 0; j >>= 1) {
#pragma unroll
            for (int i = 0; i < N; ++i) {
                const int l = i ^ j;
                if (l > i) { if ((i & k) == 0) cmpx(v[i], v[l]); else cmpx(v[l], v[i]); }
            }
        }
    }
}
template <int N> DEVI void bitonic_merge_desc(float (&v)[N]) {
#pragma unroll
    for (int j = N >> 1; j > 0; j >>= 1) {
#pragma unroll
        for (int i = 0; i < N; ++i) { const int l = i ^ j; if (l > i) cmpx(v[i], v[l]); }
    }
}
DEVI void merge_top16(float (&a)[16], const float (&b)[16]) {
#pragma unroll
    for (int i = 0; i < 16; ++i) a[i] = fmaxf(a[i], b[15 - i]);
    bitonic_merge_desc<16>(a);
}
DEVI float pack_low(float v, unsigned mask, unsigned code) { return __uint_as_float((__float_as_uint(v) & ~mask) | code); }
DEVI void pk_stage2(const float (&A)[16], const float (&B)[16], float (&T)[16]) {
    float a[16], b[16];
#pragma unroll
    for (int i = 0; i < 16; ++i) { a[i] = pack_low(A[i], 127u, 0u); b[i] = pack_low(B[i], 127u, 0u); }
#define CAND(i, j) pack_low(a[i] + b[j], 255u, (unsigned)((i) * 16 + (j)))
#pragma unroll
    for (int j = 0; j < 16; ++j) T[j] = CAND(0, j);
    float G[16];
#pragma unroll
    for (int j = 0; j < 8; ++j) { G[j] = CAND(1, j); G[15 - j] = CAND(8 + j, 0); }
    bitonic_merge_desc<16>(G);
    merge_top16(T, G);
    G[0] = CAND(2, 0); G[1] = CAND(2, 1); G[2] = CAND(2, 2); G[3] = CAND(2, 3); G[4] = CAND(2, 4);
    G[5] = CAND(3, 0); G[6] = CAND(3, 1); G[7] = CAND(3, 2); G[8] = CAND(3, 3);
    G[9] = CAND(4, 0); G[10] = CAND(4, 1); G[11] = CAND(4, 2);
    G[12] = CAND(5, 0); G[13] = CAND(5, 1); G[14] = CAND(6, 0); G[15] = CAND(6, 1);
    bitonic_sort_desc<16>(G);
    merge_top16(T, G);
    G[0] = CAND(7, 0); G[1] = CAND(7, 1);
#pragma unroll
    for (int i = 2; i < 16; ++i) G[i] = -3.0e38f;
    merge_top16(T, G);
#undef CAND
}

DEVI void phase_topk(const Params& p, int l, int nrows, unsigned char* smem) {
    const int tid = tidx(), lane = tid & 63, wave = tid >> 6, r16 = lane & 15, g4 = lane >> 4;
    const bf16_t* Q = (const bf16_t*)(p.ws + WS_P);
    int* RIDX = (int*)(p.ws + WS_RIDX);
    float* RGATE = (float*)(p.ws + WS_RGATE);
    unsigned char* klds = smem;
    float* lists = (float*)(smem + 65536) + wave * (16 * 33);
    const int rows_per_chunk = nrows / 64, npass = rows_per_chunk / 16;
    for (int task = blockIdx.x; task < 512; task += gridDim.x) {
        const int h = task & 7, chunk = task >> 3;
        __syncthreads();
        {
            const unsigned char* ksrc = (const unsigned char*)((const bf16_t*)(p.ws + WS_KB) + ((size_t)l * 8 + h) * 2 * 128 * 128);
#pragma unroll 4
            for (int it = 0; it < 16; ++it) {
                const int ci = tid + 256 * it, row = ci >> 4, c = ci & 15;
                *(u32x4*)(klds + (row * 16 + (c ^ (row & 15))) * 16) = *(const u32x4*)(ksrc + (size_t)ci * 16);
            }
        }
        __syncthreads();
        for (int pass = wave; pass < npass; pass += 4) {
            const int row0 = chunk * rows_per_chunk + pass * 16;
            float AB[2][16];
#pragma unroll
            for (int p2 = 0; p2 < 2; ++p2) {
                bf16x8 qf[4];
#pragma unroll
                for (int ks = 0; ks < 4; ++ks) qf[ks] = *(const bf16x8*)(Q + (size_t)(row0 + r16) * 2048 + h * 256 + p2 * 128 + ks * 32 + g4 * 8);
                float va[16], vb[16];
#pragma unroll
                for (int kt = 0; kt < 8; ++kt) {
                    f32x4 acc = (f32x4){0.f, 0.f, 0.f, 0.f};
#pragma unroll
                    for (int ks = 0; ks < 4; ++ks) {
                        const bf16x8 a = *(const bf16x8*)(klds + ((p2 * 128 + kt * 16 + r16) * 16 + ((ks * 4 + g4) ^ r16)) * 16);
                        acc = __builtin_amdgcn_mfma_f32_16x16x32_bf16(a, qf[ks], acc, 0, 0, 0);
                    }
#pragma unroll
                    for (int r = 0; r < 4; ++r) {
                        const float pv = pack_low(acc[r], 127u, (unsigned)(127 - (16 * kt + r) - 4 * g4));
                        if (kt < 4) va[kt * 4 + r] = pv; else vb[(kt - 4) * 4 + r] = pv;
                    }
                }
                bitonic_sort_desc<16>(va); bitonic_sort_desc<16>(vb);
                merge_top16(va, vb);
#pragma unroll
                for (int i = 0; i < 16; ++i) vb[i] = xor_lane<16>(va[i]);
                merge_top16(va, vb);
#pragma unroll
                for (int i = 0; i < 16; ++i) vb[i] = xor_lane<32>(va[i]);
                merge_top16(va, vb);
#pragma unroll
                for (int i = 0; i < 16; ++i) AB[p2][i] = va[i];
            }
            if (g4 == 0) {
#pragma unroll
                for (int i = 0; i < 16; ++i) { lists[r16 * 33 + i] = AB[0][i]; lists[r16 * 33 + 16 + i] = AB[1][i]; }
            }
            __builtin_amdgcn_wave_barrier();
            float T[16];
            pk_stage2(AB[0], AB[1], T);
            float cv[4]; int ex[4];
#pragma unroll
            for (int r = 0; r < 4; ++r) {
                const float f = (g4 == 0) ? T[r] : ((g4 == 1) ? T[4 + r] : ((g4 == 2) ? T[8 + r] : T[12 + r]));
                const unsigned code = __float_as_uint(f) & 255u;
                const float a = lists[r16 * 33 + (code >> 4)], bq = lists[r16 * 33 + 16 + (code & 15u)];
                const unsigned ua = __float_as_uint(a), ub = __float_as_uint(bq);
                ex[r] = (int)((127u - (ua & 127u)) * 128u + (127u - (ub & 127u)));
                cv[r] = __uint_as_float(ua & ~127u) + __uint_as_float(ub & ~127u);
            }
            float m = fmaxf(fmaxf(cv[0], cv[1]), fmaxf(cv[2], cv[3]));
            m = fmaxf(m, xor_lane<16>(m)); m = fmaxf(m, xor_lane<32>(m));
            float e[4], s = 0.f;
#pragma unroll
            for (int r = 0; r < 4; ++r) { e[r] = __expf(cv[r] - m); s += e[r]; }
            s += xor_lane<16>(s); s += xor_lane<32>(s);
            const float inv = 1.f / s;
            const size_t o = (size_t)(row0 + r16) * 128 + h * 16 + g4 * 4;
            *(int4*)(RIDX + o) = make_int4(ex[0], ex[1], ex[2], ex[3]);
            *(float4*)(RGATE + o) = make_float4(e[0] * inv, e[1] * inv, e[2] * inv, e[3] * inv);
            __builtin_amdgcn_wave_barrier();
        }
    }
}

DEVI void peer_row_epilogue(const Params& p, int l, int r, int lane, const float (&acc)[16]) {
    bf16_t* H = (bf16_t*)(p.ws + WS_H);
    float* xr = xrow_ptr(p, r);
    const int mr = row_modrow(r);
    const float* g2 = mod_ptr(p, l, mr, 5);
    float xn[16]; float ss = 0.f;
#pragma unroll
    for (int q = 0; q < 4; ++q) {
        const int c = lane * 16 + q * 4;
        const float4 x0 = *(const float4*)(xr + c), ga = *(const float4*)(g2 + c);
        xn[q * 4 + 0] = x0.x + ga.x * acc[q * 4 + 0]; xn[q * 4 + 1] = x0.y + ga.y * acc[q * 4 + 1];
        xn[q * 4 + 2] = x0.z + ga.z * acc[q * 4 + 2]; xn[q * 4 + 3] = x0.w + ga.w * acc[q * 4 + 3];
        ss += xn[q * 4 + 0] * xn[q * 4 + 0] + xn[q * 4 + 1] * xn[q * 4 + 1] + xn[q * 4 + 2] * xn[q * 4 + 2] + xn[q * 4 + 3] * xn[q * 4 + 3];
    }
    ss = wave_sum(ss);
    const float rs = rsqrtf(ss * (1.f / 1024.f) + 1e-6f);
    if (l == 0) {
        const float* gain = sp_ptr(p, SP_NORM1 + D);
        const float* sh = mod_ptr(p, 1, mr, 0);
        const float* sc = mod_ptr(p, 1, mr, 1);
#pragma unroll
        for (int q = 0; q < 4; ++q) {
            const int c = lane * 16 + q * 4;
            *(float4*)(xr + c) = make_float4(xn[q * 4 + 0], xn[q * 4 + 1], xn[q * 4 + 2], xn[q * 4 + 3]);
            const float4 g = *(const float4*)(gain + c), a = *(const float4*)(sc + c), bb = *(const float4*)(sh + c);
            uint2 o;
            o.x = cvt_pk_bf16(xn[q * 4 + 0] * rs * g.x * (1.f + a.x) + bb.x, xn[q * 4 + 1] * rs * g.y * (1.f + a.y) + bb.y);
            o.y = cvt_pk_bf16(xn[q * 4 + 2] * rs * g.z * (1.f + a.z) + bb.z, xn[q * 4 + 3] * rs * g.w * (1.f + a.w) + bb.w);
            *(uint2*)(H + (size_t)r * D + c) = o;
        }
    } else {
        const float* gain = sp_ptr(p, SP_NORMF);
#pragma unroll
        for (int q = 0; q < 4; ++q) {
            const int c = lane * 16 + q * 4;
            const float4 g = *(const float4*)(gain + c);
            *(float4*)(xr + c) = make_float4(xn[q * 4 + 0] * rs * g.x, xn[q * 4 + 1] * rs * g.y, xn[q * 4 + 2] * rs * g.z, xn[q * 4 + 3] * rs * g.w);
        }
    }
}

struct PeerRowBatch { u32x3 uu[8]; int ev; float gate; };
DEVI void peer_rows_issue(PeerRowBatch& B, int t, int lane, int idx0, int idx1, float gt0, float gt1, const unsigned char* U8, const unsigned char* V8) {
    const int idxr = (t < 8) ? idx0 : idx1;
    const float gtr = (t < 8) ? gt0 : gt1;
    B.gate = __shfl(gtr, (t & 7) * 8 + (lane & 7));
    B.ev = __shfl(idxr, (t & 7) * 8 + (lane & 7));
#pragma unroll
    for (int j = 0; j < 8; ++j) {
        const int e = __builtin_amdgcn_readlane(idxr, (t & 7) * 8 + j);
        B.uu[j] = *(const u32x3*)(U8 + (size_t)e * 768 + lane * 12);
    }
}
DEVI void peer_rows_compute(const PeerRowBatch& B, int lane, const f32x2 (&hv)[8], f32x2 (&acc)[8], const unsigned char* V8) {
    u32x3 vv[8];
#pragma unroll
    for (int j = 0; j < 8; ++j) {
        const int e = __builtin_amdgcn_readlane(B.ev, j);
        vv[j] = *(const u32x3*)(V8 + (size_t)e * 768 + lane * 12);
    }
    float s[8];
#pragma unroll
    for (int j = 0; j < 8; j += 2) {
        const u32x6 w6 = (u32x6){B.uu[j][0], B.uu[j][1], B.uu[j][2], B.uu[j + 1][0], B.uu[j + 1][1], B.uu[j + 1][2]};
        const f32x32 f = __builtin_amdgcn_cvt_scalef32_pk32_f32_fp6(w6, 1.0f);
        f32x2 a2 = (f32x2){0.f, 0.f}, b2 = (f32x2){0.f, 0.f};
#pragma unroll
        for (int q = 0; q < 8; ++q) {
            a2 = (f32x2){f[2 * q], f[2 * q + 1]} * hv[q] + a2;
            b2 = (f32x2){f[16 + 2 * q], f[16 + 2 * q + 1]} * hv[q] + b2;
        }
        s[j] = a2.x + a2.y; s[j + 1] = b2.x + b2.y;
    }
    float t4[4], t2[2], tot;
#pragma unroll
    for (int i = 0; i < 4; ++i) {
        const float mine = (lane & 1) ? s[2 * i + 1] : s[2 * i], other = (lane & 1) ? s[2 * i] : s[2 * i + 1];
        t4[i] = mine + xor_lane<1>(other);
    }
#pragma unroll
    for (int i = 0; i < 2; ++i) {
        const float mine = (lane & 2) ? t4[2 * i + 1] : t4[2 * i], other = (lane & 2) ? t4[2 * i] : t4[2 * i + 1];
        t2[i] = mine + xor_lane<2>(other);
    }
    {
        const float mine = (lane & 4) ? t2[1] : t2[0], other = (lane & 4) ? t2[0] : t2[1];
        tot = mine + xor_lane<4>(other);
    }
    tot += xor_lane<8>(tot); tot += xor_lane<16>(tot); tot += xor_lane<32>(tot);
    const float w = B.gate * gelu_f(tot * (1.f / 64.f)) * 0.5f;
#pragma unroll
    for (int j = 0; j < 8; j += 2) {
        const float wa = readlane_f(w, j), wb = readlane_f(w, j + 1);
        const f32x2 wa2 = (f32x2){wa, wa}, wb2 = (f32x2){wb, wb};
        const u32x6 w6 = (u32x6){vv[j][0], vv[j][1], vv[j][2], vv[j + 1][0], vv[j + 1][1], vv[j + 1][2]};
        const f32x32 f = __builtin_amdgcn_cvt_scalef32_pk32_f32_fp6(w6, 1.0f);
#pragma unroll
        for (int q = 0; q < 8; ++q) {
            acc[q] = wa2 * (f32x2){f[2 * q], f[2 * q + 1]} + acc[q];
            acc[q] = wb2 * (f32x2){f[16 + 2 * q], f[16 + 2 * q + 1]} + acc[q];
        }
    }
}
DEVI void phase_peer_rows(const Params& p, int l, int nrows, unsigned char* smem) {
    const int lane = tidx() & 63, wave = tidx() >> 6;
    const bf16_t* H = (const bf16_t*)(p.ws + WS_H);
    const unsigned char* U8 = p.ws + WS_UB + (size_t)l * NEXP * 768;
    const unsigned char* V8 = p.ws + WS_VB + (size_t)l * NEXP * 768;
    const int* RIDX = (const int*)(p.ws + WS_RIDX);
    const float* RGATE = (const float*)(p.ws + WS_RGATE);
    uint2* lst = (uint2*)smem + wave * 128;
#pragma unroll 1
    for (int r = blockIdx.x * 4 + wave; r < nrows; r += gridDim.x * 4) {
        const u32x4 pa = *(const u32x4*)(H + (size_t)r * D + lane * 16), pb = *(const u32x4*)(H + (size_t)r * D + lane * 16 + 8);
        f32x2 hv[8];
        {
            const u32x4 a = pa, b = pb;
            const f32x4* sp4 = (const f32x4*)((const float*)(p.ws + WS_SSP) + (size_t)r * 8);
            const f32x4 s0 = sp4[0], s1 = sp4[1];
            const float ss = ((s0.x + s0.y) + (s0.z + s0.w)) + ((s1.x + s1.y) + (s1.z + s1.w));
            const float rs = rsqrtf(ss * (1.f / 1024.f) + 1e-6f);
            const float4* sh4 = (const float4*)(mod_ptr(p, l, row_modrow(r), 3) + lane * 16);
            const float4 h0 = sh4[0], h1 = sh4[1], h2 = sh4[2], h3 = sh4[3];
            hv[0] = (f32x2){rs * lo_f(a.x) + h0.x, rs * hi_f(a.x) + h0.y}; hv[1] = (f32x2){rs * lo_f(a.y) + h0.z, rs * hi_f(a.y) + h0.w};
            hv[2] = (f32x2){rs * lo_f(a.z) + h1.x, rs * hi_f(a.z) + h1.y}; hv[3] = (f32x2){rs * lo_f(a.w) + h1.z, rs * hi_f(a.w) + h1.w};
            hv[4] = (f32x2){rs * lo_f(b.x) + h2.x, rs * hi_f(b.x) + h2.y}; hv[5] = (f32x2){rs * lo_f(b.y) + h2.z, rs * hi_f(b.y) + h2.w};
            hv[6] = (f32x2){rs * lo_f(b.z) + h3.x, rs * hi_f(b.z) + h3.y}; hv[7] = (f32x2){rs * lo_f(b.w) + h3.z, rs * hi_f(b.w) + h3.w};
        }
        int idx0 = RIDX[(size_t)r * 128 + lane], idx1 = RIDX[(size_t)r * 128 + 64 + lane];
        float gt0 = RGATE[(size_t)r * 128 + lane], gt1 = RGATE[(size_t)r * 128 + 64 + lane];
        {
            const int b0 = idx0 >> 10, b1 = idx1 >> 10;
            int basec = 0, pos0 = 0, pos1 = 0;
#pragma unroll
            for (int bb = 0; bb < 16; ++bb) {
                const unsigned long long m0 = __ballot(b0 == bb), m1 = __ballot(b1 == bb);
                const int c0 = __popcll(m0);
                const int below0 = __builtin_amdgcn_mbcnt_hi((unsigned)(m0 >> 32), __builtin_amdgcn_mbcnt_lo((unsigned)m0, 0));
                const int below1 = __builtin_amdgcn_mbcnt_hi((unsigned)(m1 >> 32), __builtin_amdgcn_mbcnt_lo((unsigned)m1, 0));
                if (b0 == bb) pos0 = basec + below0;
                if (b1 == bb) pos1 = basec + c0 + below1;
                basec += c0 + __popcll(m1);
            }
            __builtin_amdgcn_wave_barrier();
            lst[pos0] = make_uint2((unsigned)idx0, __float_as_uint(gt0));
            lst[pos1] = make_uint2((unsigned)idx1, __float_as_uint(gt1));
            __builtin_amdgcn_wave_barrier();
            const uint2 e0 = lst[lane], e1 = lst[64 + lane];
            idx0 = (int)e0.x; gt0 = __uint_as_float(e0.y); idx1 = (int)e1.x; gt1 = __uint_as_float(e1.y);
            __builtin_amdgcn_wave_barrier();
        }
        f32x2 acc[8];
#pragma unroll
        for (int i = 0; i < 8; ++i) acc[i] = (f32x2){0.f, 0.f};
        PeerRowBatch A, Bq;
        peer_rows_issue(A, 0, lane, idx0, idx1, gt0, gt1, U8, V8);
#pragma unroll 1
        for (int t = 0; t < 16; t += 2) {
            peer_rows_issue(Bq, t + 1, lane, idx0, idx1, gt0, gt1, U8, V8);
            peer_rows_compute(A, lane, hv, acc, V8);
            peer_rows_issue(A, (t + 2 < 16) ? t + 2 : 15, lane, idx0, idx1, gt0, gt1, U8, V8);
            peer_rows_compute(Bq, lane, hv, acc, V8);
        }
        float ar[16];
#pragma unroll
        for (int i = 0; i < 8; ++i) { ar[2 * i] = acc[i].x; ar[2 * i + 1] = acc[i].y; }
        peer_row_epilogue(p, l, r, lane, ar);
    }
}

DEVI void phase_peer(const Params& p, int l, int nrows, unsigned char* smem) {
    phase_peer_rows(p, l, nrows, smem);
}

constexpr int N_PHASES = 23;
template <int K>
DEVI void run_kind(const Params& pin, int lin, unsigned char* smem) {
    Params p = pin; int l = lin;
    {
        unsigned long long w = (unsigned long long)pin.ws, o = (unsigned long long)pin.out;
        asm volatile("" : "+s"(w), "+s"(o), "+s"(l));
        p.ws = (unsigned char*)(__attribute__((address_space(1))) unsigned char*)w;
        p.out = (float*)(__attribute__((address_space(1))) float*)o;
    }
    unsigned char* ws = p.ws;
    const int nrows_act = (l == 0) ? NTOK : NX;
    if (K == 10) phase_prep(p, smem);
    if (K == 11) phase_modred(p);
    if (K == 0) { phase_norm(p, l, 0, NTOK); phase_qbias(p); }
    if (K == 1) phase_gemm<0>(p, (const bf16_t*)(ws + WS_H), (const bf16_t*)(ws + WS_WINT) + (size_t)l * INWP * 1024, NTOK, INWP, INW, (bf16_t*)(ws + WS_P), INW, l, smem);
    if (K == 2) phase_mix1(p, l, smem);
    if (K == 3) phase_gdn_scan(p, l, smem);
    if (K == 4) phase_gdn_finish(p, l, nrows_act);
    if (K == 5) phase_gemm<1>(p, (const bf16_t*)(ws + WS_Y), (const bf16_t*)(ws + WS_WOUTT) + (size_t)l * 1024 * 1024, nrows_act, 1024, 1024, (bf16_t*)(ws + WS_H), 1024, l, smem);
    if (K == 7) phase_gemm<2>(p, (const bf16_t*)(ws + WS_H), (const bf16_t*)(ws + WS_WQT) + (size_t)l * 2048 * 1024, nrows_act, 2048, 2048, (bf16_t*)(ws + WS_P), 2048, l, smem);
    if (K == 8) phase_topk(p, l, nrows_act, smem);
    if (K == 9) phase_peer(p, l, nrows_act, smem);
}

#ifndef PROBE_MASK
#define PROBE_MASK 0
#endif
#if N_LAUNCH_MODE == 0
template <int K>
__global__ void __launch_bounds__(NT, 2) phase_kernel(Params p, int l) {
    __shared__ __attribute__((aligned(1024))) unsigned char smem[SMEM_BYTES + 16];
    run_kind<K>(p, l, smem);
}
#else
__global__ void __launch_bounds__(NT, 2) mk_kernel(Params p) {
    __shared__ __attribute__((aligned(1024))) unsigned char smem[SMEM_BYTES + 16];
    if (threadIdx.x == 0) *(uint4*)(smem + SMEM_BYTES) = make_uint4(0u, 0u, 0u, 0u);
    __syncthreads();
    XcdBarrier bar = xcd_barrier_post((unsigned*)(p.ws + WS_BAR), (volatile LAS unsigned*)(smem + SMEM_BYTES));
    run_kind<10>(p, 0, smem); xcd_barrier_census(bar); xcd_barrier(bar);
    run_kind<11>(p, 0, smem); xcd_barrier(bar);
#define MK_LAYER(l) do { \
        if (l == 0) { run_kind<0>(p, l, smem); xcd_barrier(bar); } \
        run_kind<1>(p, l, smem); xcd_barrier(bar); if (PROBE_MASK & (1 << 1)) { run_kind<1>(p, l, smem); xcd_barrier(bar); } \
        run_kind<2>(p, l, smem); xcd_barrier(bar); if (PROBE_MASK & (1 << 2)) { run_kind<2>(p, l, smem); xcd_barrier(bar); } \
        run_kind<3>(p, l, smem); xcd_barrier(bar); if (PROBE_MASK & (1 << 3)) { run_kind<3>(p, l, smem); xcd_barrier(bar); } \
        run_kind<4>(p, l, smem); xcd_barrier(bar); if (PROBE_MASK & (1 << 4)) { run_kind<4>(p, l, smem); xcd_barrier(bar); } \
        run_kind<5>(p, l, smem); xcd_barrier(bar); if (PROBE_MASK & (1 << 5)) { run_kind<5>(p, l, smem); xcd_barrier(bar); } \
        run_kind<7>(p, l, smem); xcd_barrier(bar); if (PROBE_MASK & (1 << 7)) { run_kind<7>(p, l, smem); xcd_barrier(bar); } \
        run_kind<8>(p, l, smem); xcd_barrier(bar); if (PROBE_MASK & (1 << 8)) { run_kind<8>(p, l, smem); xcd_barrier(bar); } \
        run_kind<9>(p, l, smem); if (l == 0) xcd_barrier(bar); \
    } while (0)
    MK_LAYER(0);
    MK_LAYER(1);
#undef MK_LAYER
}
#endif

extern "C" void kernel_launch(void* const* d_in, const int* in_sizes, int n_in, void* d_out, int out_size, void* d_ws, size_t ws_size, hipStream_t stream) {
    if (n_in != 22 || ws_size < WS_TOTAL) { fprintf(stderr, "kernel_launch: unexpected n_in %d or ws_size %zu < %zu\n", n_in, ws_size, (size_t)WS_TOTAL); return; }
    Params p{};
    for (int i = 0; i < 22; ++i) p.in[i] = (const float*)d_in[i];
    p.out = (float*)d_out; p.ws = (unsigned char*)d_ws;
#if N_LAUNCH_MODE == 0
    const dim3 g(2048), b(NT);
    (void)hipMemsetAsync((unsigned char*)d_ws + WS_BAR, 0, 16384, stream);
    hipLaunchKernelGGL(phase_kernel<10>, g, b, 0, stream, p, 0);
    hipLaunchKernelGGL(phase_kernel<11>, g, b, 0, stream, p, 0);
    for (int l = 0; l < 2; ++l) {
        if (l == 0) hipLaunchKernelGGL(phase_kernel<0>, g, b, 0, stream, p, l);
        hipLaunchKernelGGL(phase_kernel<1>, g, b, 0, stream, p, l);
        hipLaunchKernelGGL(phase_kernel<2>, g, b, 0, stream, p, l);
        hipLaunchKernelGGL(phase_kernel<3>, dim3(24), b, 0, stream, p, l);
        hipLaunchKernelGGL(phase_kernel<4>, g, b, 0, stream, p, l);
        hipLaunchKernelGGL(phase_kernel<5>, g, b, 0, stream, p, l);
        hipLaunchKernelGGL(phase_kernel<7>, g, b, 0, stream, p, l);
        hipLaunchKernelGGL(phase_kernel<8>, g, b, 0, stream, p, l);
        hipLaunchKernelGGL(phase_kernel<9>, g, b, 0, stream, p, l);
    }
#else
    static int grid = 0;
    if (grid == 0) {
        int dev = 0, cus = 0, per_cu = 0;
        hipGetDevice(&dev);
        hipDeviceGetAttribute(&cus, hipDeviceAttributeMultiprocessorCount, dev);
        hipOccupancyMaxActiveBlocksPerMultiprocessor(&per_cu, (const void*)mk_kernel, NT, 0);
        if (per_cu > 2) per_cu = 2;
        if (per_cu < 1) per_cu = 1;
        grid = cus * per_cu;
    }
    hipMemsetAsync((unsigned char*)d_ws + WS_BAR, 0, 16384, stream);
    hipLaunchKernelGGL(mk_kernel, dim3(grid), dim3(NT), 0, stream, p);
#endif
}
```

```cpp
#include <hip/hip_runtime.h>
#include <stdint.h>
#include <stdio.h>

#define DEVI __device__ __forceinline__
typedef unsigned short bf16_t;
typedef __attribute__((ext_vector_type(8))) short bf16x8;
typedef __attribute__((ext_vector_type(4))) float f32x4;
typedef __attribute__((ext_vector_type(4))) unsigned u32x4;
typedef float f32x2 __attribute__((ext_vector_type(2)));

#ifndef N_LAUNCH_MODE
#define N_LAUNCH_MODE 1
#endif

constexpr int D = 1024, NB = 8, SEQ = 2048, LC = 256;
constexpr int NX = NB * SEQ, NC = NB * LC, NTOK = NX + NC;
constexpr int INW = 2456, INWP = 2560;
constexpr int C_POOL = 0, C_GQKV = 256, C_GZ = 1408, C_GBA = 1792, C_AQ = 1816, C_AK = 2200, C_AV = 2328;
constexpr int NEXP = 16384;
constexpr int NT = 256;
constexpr int SMEM_BYTES = 73984;

constexpr size_t al256(size_t x) { return (x + 255) & ~(size_t)255; }
constexpr size_t WS_BAR   = 0;
constexpr size_t WS_SMALL = 16384;
constexpr size_t WS_MODP  = WS_SMALL + 262144;
constexpr size_t WS_MOD   = WS_MODP  + al256((size_t)8 * 2 * 9 * 6144 * 4);
constexpr size_t WS_ROPE  = WS_MOD   + al256((size_t)2 * 9 * 6144 * 4);
constexpr size_t WS_WINT  = WS_ROPE  + al256((size_t)2 * 2048 * 32 * 4);
constexpr size_t WS_WOUTT = WS_WINT  + al256((size_t)2 * INWP * 1024 * 2);
constexpr size_t WS_WQT   = WS_WOUTT + al256((size_t)2 * 1024 * 1024 * 2);
constexpr size_t WS_KB    = WS_WQT   + al256((size_t)2 * 2048 * 1024 * 2);
constexpr size_t WS_UB    = WS_KB    + al256((size_t)2 * 8 * 2 * 128 * 128 * 2);
constexpr size_t WS_VB    = WS_UB    + al256((size_t)2 * NEXP * 768);
constexpr size_t WS_XC    = WS_VB    + al256((size_t)2 * NEXP * 768);
constexpr size_t WS_H     = WS_XC    + al256((size_t)NC * 1024 * 4);
constexpr size_t WS_Y     = WS_H     + al256((size_t)NTOK * 1024 * 2);
constexpr size_t WS_P     = WS_Y     + al256((size_t)NTOK * 1024 * 2);
constexpr size_t CH_TASK_BYTES = 40960;
constexpr size_t WS_CH    = WS_P     + al256((size_t)NTOK * INW * 2);
constexpr size_t WS_GL    = WS_CH    + al256((size_t)96 * 36 * CH_TASK_BYTES);
constexpr size_t WS_GO    = WS_GL    + al256((size_t)96 * 36 * 4);
constexpr size_t WS_RIDX  = WS_GO    + al256((size_t)2 * NTOK * 384 * 2);
constexpr size_t WS_RGATE = WS_RIDX  + al256((size_t)NTOK * 128 * 4);
constexpr size_t WS_SSP   = WS_RGATE + al256((size_t)NTOK * 128 * 4);
constexpr size_t WS_BQ    = WS_SSP   + al256((size_t)NTOK * 16 * 4);
constexpr size_t WS_TOTAL = WS_BQ    + al256((size_t)2 * 9 * 2048 * 4);

struct Params {
    const float* in[22];
    float* out;
    unsigned char* ws;
    int pad0, pad1;
};
constexpr int SP_NORM1 = 0, SP_NORM2 = 2048, SP_CONVW = 4096, SP_ALOG = 4096 + 11520, SP_DTB = SP_ALOG + 32, SP_GDNN = SP_DTB + 32,
              SP_WPOOL = SP_GDNN + 128, SP_PSCALE = SP_WPOOL + 32768, SP_SINK = SP_PSCALE + 512, SP_NORMF = SP_SINK + 32, SP_END = SP_NORMF + 1024;
static_assert(SP_END * 4 <= 262144, "small block");
enum { I_X = 0, I_C, I_CTX, I_CCTX, I_WADA, I_BADA, I_NORM1, I_NORM2, I_WIN, I_CONVW, I_ALOG, I_DTB, I_GDNN, I_WPOOL, I_PSCALE, I_SINK, I_WOUT, I_WQ, I_KEYS, I_PU, I_PV, I_NORMF };

DEVI int tidx() { int t = threadIdx.x; asm volatile("" : "+v"(t)); return t; }
DEVI float bf2f(bf16_t v) { return __uint_as_float(((unsigned)v) << 16); }
typedef __bf16 bf16x2_t __attribute__((ext_vector_type(2)));
DEVI unsigned cvt_pk_bf16(float lo, float hi) { bf16x2_t v; v.x = (__bf16)lo; v.y = (__bf16)hi; return __builtin_bit_cast(unsigned, v); }
DEVI bf16_t f2bf(float f) { return (bf16_t)(cvt_pk_bf16(f, 0.f) & 0xffffu); }
DEVI float lo_f(unsigned u) { return __uint_as_float(u << 16); }
DEVI float hi_f(unsigned u) { return __uint_as_float(u & 0xffff0000u); }
template <int M>
DEVI float xor_lane(float v) {
    if constexpr (M == 1) return __builtin_bit_cast(float, __builtin_amdgcn_update_dpp(0, __builtin_bit_cast(int, v), 0xB1, 0xF, 0xF, true));
    else if constexpr (M == 2) return __builtin_bit_cast(float, __builtin_amdgcn_update_dpp(0, __builtin_bit_cast(int, v), 0x4E, 0xF, 0xF, true));
    else if constexpr (M == 4) {
        const int h = __builtin_amdgcn_update_dpp(0, __builtin_bit_cast(int, v), 0x141, 0xF, 0xF, true);
        return __builtin_bit_cast(float, __builtin_amdgcn_update_dpp(0, h, 0x1B, 0xF, 0xF, true));
    }
    else if constexpr (M == 8) return __builtin_bit_cast(float, __builtin_amdgcn_update_dpp(0, __builtin_bit_cast(int, v), 0x128, 0xF, 0xF, true));
    else {
        typedef unsigned u32x2_t __attribute__((ext_vector_type(2)));
        const unsigned u = __builtin_bit_cast(unsigned, v);
        const u32x2_t r = (M == 16) ? __builtin_amdgcn_permlane16_swap(u, u, false, false) : __builtin_amdgcn_permlane32_swap(u, u, false, false);
        return __builtin_bit_cast(float, (__lane_id() & M) ? r.x : r.y);
    }
}
DEVI float row_share_f(float v, int n) {
    const int u = __builtin_bit_cast(int, v);
    int r = u;
    switch (n) {
#define RS_CASE(k) case k: r = __builtin_amdgcn_update_dpp(0, u, 0x150 + k, 0xF, 0xF, true); break;
        RS_CASE(0) RS_CASE(1) RS_CASE(2) RS_CASE(3) RS_CASE(4) RS_CASE(5) RS_CASE(6) RS_CASE(7)
        RS_CASE(8) RS_CASE(9) RS_CASE(10) RS_CASE(11) RS_CASE(12) RS_CASE(13) RS_CASE(14) RS_CASE(15)
#undef RS_CASE
    }
    return __builtin_bit_cast(float, r);
}
DEVI float wave_sum(float v) {
    v += xor_lane<1>(v); v += xor_lane<2>(v); v += xor_lane<4>(v); v += xor_lane<8>(v); v += xor_lane<16>(v); v += xor_lane<32>(v);
    return v;
}
DEVI float wave_max(float v) {
    v = fmaxf(v, xor_lane<1>(v)); v = fmaxf(v, xor_lane<2>(v)); v = fmaxf(v, xor_lane<4>(v)); v = fmaxf(v, xor_lane<8>(v));
    v = fmaxf(v, xor_lane<16>(v)); v = fmaxf(v, xor_lane<32>(v));
    return v;
}
DEVI float silu_f(float x) { return x * __builtin_amdgcn_rcpf(1.f + __expf(-x)); }
DEVI float sigmoid_f(float x) { return __builtin_amdgcn_rcpf(1.f + __expf(-x)); }
DEVI float softplus_f(float x) { return fmaxf(x, 0.f) + log1pf(__expf(-fabsf(x))); }
DEVI float gelu_f(float x) { return 0.5f * x * (1.f + erff(x * 0.70710678118654752f)); }

DEVI int row_modrow(int r) { return r < NX ? (r >> 11) : 8; }
DEVI float* xrow_ptr(const Params& p, int r) {
    return r < NX ? p.out + (size_t)r * D : (float*)(p.ws + WS_XC) + (size_t)(r - NX) * D;
}
DEVI const float* xin_ptr(const Params& p, int r) {
    return r < NX ? p.in[I_X] + (size_t)r * D : p.in[I_CTX] + (size_t)(r - NX) * D;
}
DEVI const float* sp_ptr(const Params& p, int off) { return (const float*)(p.ws + WS_SMALL) + off; }
DEVI const float* mod_ptr(const Params& p, int l, int mrow, int chunk) {
    return (const float*)(p.ws + WS_MOD) + ((size_t)(l * 9 + mrow) * 6 + chunk) * D;
}

#define XB_TMO      128
#define XB_XCNT(j)  (256  + 64 * (j))
#define XB_XSUB(j)  (1280 + 64 * (j))
#define XB_XGEN(j)  (2304 + 64 * (j))
#define XB_TOP      3328
#define XB_TOPGEN   3392
#define XCD_BAR_WORDS 3456
#define XB_SPIN_CAP (1u << 22)
#define LAS __attribute__((address_space(3)))
DEVI unsigned xb_ld(unsigned* p)              { return __hip_atomic_load(p, __ATOMIC_RELAXED, __HIP_MEMORY_SCOPE_AGENT); }
DEVI unsigned xb_add(unsigned* p, unsigned v) { return __hip_atomic_fetch_add(p, v, __ATOMIC_RELAXED, __HIP_MEMORY_SCOPE_AGENT); }
DEVI unsigned xb_xcc_id() { return (unsigned)__builtin_amdgcn_s_getreg((3 << 11) | 20) & 0xFu; }
#define XB_SPIN(cond, bar) do { unsigned _sp = 0; while (cond) { __builtin_amdgcn_s_sleep(1); \
    if ((++_sp & 255u) == 0u) { if (xb_ld(&(bar)[XB_TMO])) break; if (_sp > XB_SPIN_CAP) { atomicAdd(&(bar)[XB_TMO], 1u); break; } } } } while (0)
struct XcdBarrier { unsigned* bar; unsigned x; volatile LAS unsigned* st; };
DEVI XcdBarrier xcd_barrier_post(unsigned* bar, volatile LAS unsigned* st) {
    XcdBarrier b; b.bar = bar; b.x = xb_xcc_id(); b.st = st;
    if (threadIdx.x == 0) (void)xb_add(&bar[XB_XCNT(b.x)], 1u);
    return b;
}
DEVI void xcd_barrier_complete(unsigned* bar, unsigned x, unsigned& nloc, unsigned& nx) {
    const unsigned G = gridDim.x * gridDim.y * gridDim.z;
    unsigned sum, cnt, mine, sp = 0u;
    for (;;) {
        sum = 0u; cnt = 0u; mine = 0u;
#pragma unroll
        for (unsigned j = 0; j < 16; ++j) { const unsigned c = xb_ld(&bar[XB_XCNT(j)]); sum += c; cnt += (c > 0u) ? 1u : 0u; mine = (j == x) ? c : mine; }
        if (sum == G) break;
        __builtin_amdgcn_s_sleep(1);
        if ((++sp & 255u) == 0u) { if (xb_ld(&bar[XB_TMO])) break; if (sp > XB_SPIN_CAP) { atomicAdd(&bar[XB_TMO], 1u); break; } }
    }
    nloc = mine > 0u ? mine : 1u; nx = cnt > 0u ? cnt : 1u;
}
DEVI void xcd_barrier_census(const XcdBarrier& b) {
    if (threadIdx.x == 0) {
        unsigned nloc, nx;
        xcd_barrier_complete(b.bar, b.x, nloc, nx);
        b.st[0] = nloc; b.st[1] = nx;
    }
    __syncthreads();
}
DEVI void xcd_barrier(const XcdBarrier& b_in) {
    XcdBarrier b; b.bar = b_in.bar; b.st = b_in.st; b.x = xb_xcc_id();
    asm volatile("s_waitcnt vmcnt(0)" ::: "memory");
    __syncthreads();
    if (threadIdx.x == 0) {
        unsigned* bar = b.bar;
        __builtin_amdgcn_s_waitcnt(0);
        const unsigned nloc = b.st[0], nx = b.st[1];
        const unsigned old = xb_add(&bar[XB_XSUB(b.x)], 1u);
        const unsigned gen = old / nloc;
        if (old + 1u == (gen + 1u) * nloc) {
            __builtin_amdgcn_fence(__ATOMIC_RELEASE, "agent");
            asm volatile("s_waitcnt vmcnt(0)" ::: "memory");
            const unsigned og = xb_add(&bar[XB_TOP], 1u);
            const unsigned tg = og / nx;
            if (og + 1u == (tg + 1u) * nx) xb_add(&bar[XB_TOPGEN], 1u);
            else XB_SPIN(xb_ld(&bar[XB_TOPGEN]) == tg, bar);
            __builtin_amdgcn_fence(__ATOMIC_ACQUIRE, "agent");
            xb_add(&bar[XB_XGEN(b.x)], 1u);
            asm volatile("s_waitcnt vmcnt(0)" ::: "memory");
        } else {
            XB_SPIN(xb_ld(&bar[XB_XGEN(b.x)]) == gen, bar);
            __builtin_amdgcn_fence(__ATOMIC_ACQUIRE, "agent");
            asm volatile("s_waitcnt vmcnt(0)" ::: "memory");
        }
    }
    __syncthreads();
}

DEVI void cvt_bf16_job(const float* __restrict__ src, bf16_t* __restrict__ dst, size_t n) {
    const size_t n8 = n >> 3;
    for (size_t i = (size_t)blockIdx.x * NT + tidx(); i < n8; i += (size_t)gridDim.x * NT) {
        const float4 a = ((const float4*)src)[2 * i], b = ((const float4*)src)[2 * i + 1];
        uint4 o; o.x = cvt_pk_bf16(a.x, a.y); o.y = cvt_pk_bf16(a.z, a.w); o.z = cvt_pk_bf16(b.x, b.y); o.w = cvt_pk_bf16(b.z, b.w);
        ((uint4*)dst)[i] = o;
    }
}
typedef float f32x16 __attribute__((ext_vector_type(16)));
typedef float f32x32 __attribute__((ext_vector_type(32)));
typedef unsigned u32x6 __attribute__((ext_vector_type(6)));
typedef unsigned u32x3 __attribute__((ext_vector_type(3)));
DEVI void cvt_fp6_job(const float* __restrict__ src, unsigned char* __restrict__ dst, size_t n, float scale, int part = 0, int nparts = 1) {
    const size_t n32 = n >> 5, per = n32 / (size_t)nparts, i0 = per * (size_t)part, i1 = (part + 1 == nparts) ? n32 : i0 + per;
    for (size_t i = i0 + (size_t)blockIdx.x * NT + tidx(); i < i1; i += (size_t)gridDim.x * NT) {
        f32x16 x, y;
#pragma unroll
        for (int q = 0; q < 4; ++q) {
            const float4 a = ((const float4*)src)[8 * i + q], b = ((const float4*)src)[8 * i + 4 + q];
            x[2 * q] = a.x * scale; y[2 * q] = a.y * scale; x[2 * q + 1] = a.z * scale; y[2 * q + 1] = a.w * scale;
            x[8 + 2 * q] = b.x * scale; y[8 + 2 * q] = b.y * scale; x[8 + 2 * q + 1] = b.z * scale; y[8 + 2 * q + 1] = b.w * scale;
        }
        const u32x6 w = __builtin_amdgcn_cvt_scalef32_2xpk16_fp6_f32(x, y, 1.0f);
        uint2* o = (uint2*)(dst + (i >> 5) * 1536 + (i & 31) * 24);
        o[0] = make_uint2(w[0], w[1]); o[1] = make_uint2(w[2], w[3]); o[2] = make_uint2(w[4], w[5]);
    }
}
DEVI void transpose_tile(const float* __restrict__ src, bf16_t* __restrict__ dst, int Nsrc, int k0, int n0, unsigned char* smem) {
    float* tile = (float*)smem;
    const int tid = tidx();
    __syncthreads();
    float4 tv[4];
#pragma unroll
    for (int it = 0; it < 4; ++it) {
        const int kk = it * 16 + (tid >> 4), nn = (tid & 15) * 4;
        tv[it] = (n0 + nn < Nsrc) ? *(const float4*)(src + (size_t)(k0 + kk) * Nsrc + n0 + nn) : make_float4(0.f, 0.f, 0.f, 0.f);
    }
#pragma unroll
    for (int it = 0; it < 4; ++it) {
        const int kk = it * 16 + (tid >> 4), nn = (tid & 15) * 4;
        float* d = tile + kk * 65 + nn;
        d[0] = tv[it].x; d[1] = tv[it].y; d[2] = tv[it].z; d[3] = tv[it].w;
    }
    __syncthreads();
#pragma unroll
    for (int it = 0; it < 2; ++it) {
        const int nn = it * 32 + (tid >> 3), kc = (tid & 7) * 8;
        float v[8];
#pragma unroll
        for (int j = 0; j < 8; ++j) v[j] = tile[(kc + j) * 65 + nn];
        uint4 o; o.x = cvt_pk_bf16(v[0], v[1]); o.y = cvt_pk_bf16(v[2], v[3]); o.z = cvt_pk_bf16(v[4], v[5]); o.w = cvt_pk_bf16(v[6], v[7]);
        *(uint4*)(dst + (size_t)(n0 + nn) * 1024 + k0 + kc) = o;
    }
}
DEVI void phase_prep(const Params& p, unsigned char* smem) {
    const int tid = tidx();
    unsigned char* ws = p.ws;
    {
        float* sp = (float*)(ws + WS_SMALL);
        const int gt = blockIdx.x * NT + tid, gs = gridDim.x * NT;
        for (int i = gt; i < 2048; i += gs) { sp[SP_NORM1 + i] = p.in[I_NORM1][i]; sp[SP_NORM2 + i] = p.in[I_NORM2][i]; }
        for (int i = gt; i < 11520; i += gs) sp[SP_CONVW + i] = p.in[I_CONVW][i];
        for (int i = gt; i < 24; i += gs) { sp[SP_ALOG + i] = p.in[I_ALOG][i]; sp[SP_DTB + i] = p.in[I_DTB][i]; }
        for (int i = gt; i < 128; i += gs) sp[SP_GDNN + i] = p.in[I_GDNN][i];
        for (int i = gt; i < 32768; i += gs) { const int lg = i >> 12, e = (i >> 6) & 63, c = i & 63; ((bf16_t*)(sp + SP_WPOOL))[i] = f2bf(p.in[I_WPOOL][(lg * 64 + c) * 64 + e]); }
        for (int i = gt; i < 512; i += gs) sp[SP_PSCALE + i] = p.in[I_PSCALE][i];
        for (int i = gt; i < 12; i += gs) sp[SP_SINK + i] = p.in[I_SINK][i];
        for (int i = gt; i < 1024; i += gs) sp[SP_NORMF + i] = p.in[I_NORMF][i];
    }
    cvt_bf16_job(p.in[I_KEYS], (bf16_t*)(ws + WS_KB), (size_t)2 * 8 * 2 * 128 * 128);
    {
        const int T_IN = 16 * (INWP / 64), T_OUT = 16 * 16, T_Q = 16 * 32;
        const int total = 2 * (T_IN + T_OUT + T_Q);
        for (int t = blockIdx.x; t < total; t += gridDim.x) {
            int l = t / (T_IN + T_OUT + T_Q), u = t % (T_IN + T_OUT + T_Q);
            if (u < T_IN) {
                const int kt = u / (INWP / 64), nt = u % (INWP / 64);
                transpose_tile(p.in[I_WIN] + (size_t)l * 1024 * INW, (bf16_t*)(ws + WS_WINT) + (size_t)l * INWP * 1024, INW, kt * 64, nt * 64, smem);
            } else if (u < T_IN + T_OUT) {
                u -= T_IN; const int kt = u / 16, nt = u % 16;
                transpose_tile(p.in[I_WOUT] + (size_t)l * 1024 * 1024, (bf16_t*)(ws + WS_WOUTT) + (size_t)l * 1024 * 1024, 1024, kt * 64, nt * 64, smem);
            } else {
                u -= T_IN + T_OUT; const int kt = u / 32, nt = u % 32;
                transpose_tile(p.in[I_WQ] + (size_t)l * 1024 * 2048, (bf16_t*)(ws + WS_WQT) + (size_t)l * 2048 * 1024, 2048, kt * 64, nt * 64, smem);
            }
        }
    }
    {
        float* sc = (float*)smem;
        float* modp = (float*)(ws + WS_MODP);
        for (int t = blockIdx.x; t < 2 * 8 * 24; t += gridDim.x) {
            const int l = t / 192, ks = (t % 192) / 24, cb = t % 24;
            __syncthreads();
            for (int i = tid; i < 9 * 128; i += NT) {
                const int r = i >> 7, k = i & 127;
                const float cv = (r < 8) ? p.in[I_C][r * 1024 + ks * 128 + k] : p.in[I_CCTX][ks * 128 + k];
                sc[i] = silu_f(cv);
            }
            __syncthreads();
            const int j = cb * 256 + tid;
            const float* w = p.in[I_WADA] + ((size_t)l * 1024 + ks * 128) * 6144 + j;
            float acc[9];
#pragma unroll
            for (int r = 0; r < 9; ++r) acc[r] = 0.f;
#pragma unroll 1
            for (int k0 = 0; k0 < 128; k0 += 32) {
                float wv[32];
#pragma unroll
                for (int kk = 0; kk < 32; ++kk) wv[kk] = w[(size_t)(k0 + kk) * 6144];
#pragma unroll
                for (int kk = 0; kk < 32; ++kk)
#pragma unroll
                    for (int r = 0; r < 9; ++r) acc[r] += sc[r * 128 + k0 + kk] * wv[kk];
            }
#pragma unroll
            for (int r = 0; r < 9; ++r) modp[(((size_t)ks * 2 + l) * 9 + r) * 6144 + j] = acc[r] + (ks == 0 ? p.in[I_BADA][l * 6144 + j] : 0.f);
        }
    }
    {
        float* rc = (float*)(ws + WS_ROPE); float* rs = rc + 2048 * 32;
        for (int i = blockIdx.x * NT + tid; i < 2048 * 32; i += gridDim.x * NT) {
            const int s = i >> 5, a = (i >> 4) & 1, pp = i & 15;
            const float pos = (float)(a == 0 ? (s >> 6) : (s & 63));
            const float inv = powf(10000.f, -(float)pp / 16.f);
            const float ang = pos * inv;
            rc[i] = cosf(ang); rs[i] = sinf(ang);
        }
    }
}
DEVI void phase_modred(const Params& p) {
    const float* modp = (const float*)(p.ws + WS_MODP);
    float* mod = (float*)(p.ws + WS_MOD);
    for (int i = blockIdx.x * NT + tidx(); i < 2 * 9 * 6144; i += gridDim.x * NT) {
        float s = 0.f;
#pragma unroll
        for (int ks = 0; ks < 8; ++ks) s += modp[(size_t)ks * 2 * 9 * 6144 + i];
        mod[i] = s;
    }
}

DEVI void phase_norm(const Params& p, int l, int which, int nrows) {
    const int lane = tidx() & 63, wave = tidx() >> 6;
    const float* gain = sp_ptr(p, (which == 0 ? SP_NORM1 : SP_NORM2) + l * D);
    bf16_t* H = (bf16_t*)(p.ws + WS_H);
    for (int r = blockIdx.x * 4 + wave; r < nrows; r += gridDim.x * 4) {
        const float* xr = (l == 0 && which == 0) ? xin_ptr(p, r) : xrow_ptr(p, r);
        const int mr = row_modrow(r);
        const float* sh = mod_ptr(p, l, mr, which == 0 ? 0 : 3);
        const float* sc = mod_ptr(p, l, mr, which == 0 ? 1 : 4);
        float4 v[4]; float ss = 0.f;
#pragma unroll
        for (int i = 0; i < 4; ++i) { v[i] = *(const float4*)(xr + i * 256 + lane * 4); ss += v[i].x * v[i].x + v[i].y * v[i].y + v[i].z * v[i].z + v[i].w * v[i].w; }
        ss = wave_sum(ss);
        const float rs = rsqrtf(ss * (1.f / 1024.f) + 1e-6f);
#pragma unroll
        for (int i = 0; i < 4; ++i) {
            const int c = i * 256 + lane * 4;
            const float4 g = *(const float4*)(gain + c), a = *(const float4*)(sc + c), b = *(const float4*)(sh + c);
            const float y0 = v[i].x * rs * g.x * (1.f + a.x) + b.x, y1 = v[i].y * rs * g.y * (1.f + a.y) + b.y;
            const float y2 = v[i].z * rs * g.z * (1.f + a.z) + b.z, y3 = v[i].w * rs * g.w * (1.f + a.w) + b.w;
            uint2 o; o.x = cvt_pk_bf16(y0, y1); o.y = cvt_pk_bf16(y2, y3);
            *(uint2*)(H + (size_t)r * D + c) = o;
        }
    }
}

DEVI void phase_qbias(const Params& p) {
    const int lane = tidx() & 63, wave = tidx() >> 6;
    float* BQ = (float*)(p.ws + WS_BQ);
    for (int u = blockIdx.x * 4 + wave; u < 2 * 2048; u += gridDim.x * 4) {
        const int l = u >> 11, n = u & 2047;
        const bf16_t* wr = (const bf16_t*)(p.ws + WS_WQT) + ((size_t)l * 2048 + n) * 1024 + lane * 16;
        const u32x4 a = *(const u32x4*)wr, b = *(const u32x4*)(wr + 8);
        const float w[16] = {lo_f(a.x), hi_f(a.x), lo_f(a.y), hi_f(a.y), lo_f(a.z), hi_f(a.z), lo_f(a.w), hi_f(a.w),
                             lo_f(b.x), hi_f(b.x), lo_f(b.y), hi_f(b.y), lo_f(b.z), hi_f(b.z), lo_f(b.w), hi_f(b.w)};
#pragma unroll 1
        for (int mr = 0; mr < 9; ++mr) {
            const float* sh = mod_ptr(p, l, mr, 3) + lane * 16;
            float s = 0.f;
#pragma unroll
            for (int q = 0; q < 4; ++q) { const float4 v = *(const float4*)(sh + q * 4); s += v.x * w[q * 4] + v.y * w[q * 4 + 1] + v.z * w[q * 4 + 2] + v.w * w[q * 4 + 3]; }
            s = wave_sum(s);
            if (lane == 0) BQ[((size_t)l * 9 + mr) * 2048 + n] = s;
        }
    }
}

DEVI void qgemm_topk_epilogue(const Params& p, int l, int m0, int n0, const f32x4 (&acc)[4][4], unsigned char* smem);
template <int EPI>
DEVI void phase_gemm(const Params& p, const bf16_t* __restrict__ A, const bf16_t* __restrict__ BT, int M, int Npad, int N,
                     bf16_t* C, int ldc, int l, unsigned char* smem) {
    constexpr int TILE_ELEMS = 128 * 64;
    bf16_t* lds = (bf16_t*)smem;
    const int tid = tidx(), lane = tid & 63, wave = __builtin_amdgcn_readfirstlane(tid >> 6);
    const int wm = wave >> 1, wn = wave & 1, r16 = lane & 15, q4 = lane >> 4;
    const int ntn = Npad / 128, tiles = (M / 128) * ntn;
    const int srow = lane >> 3, spc = lane & 7;
    const int nrb = M / 128, G8 = gridDim.x >> 3;
    const bool xcd_order = ((gridDim.x & 7) == 0) && (nrb % 8 == 0);
    const int rb_per = nrb >> 3, part_tiles = rb_per * ntn;
    const int xcd = blockIdx.x & 7, widx = blockIdx.x >> 3;
    const int my_first = xcd_order ? widx : (int)blockIdx.x, my_step = xcd_order ? G8 : (int)gridDim.x, my_end = xcd_order ? part_tiles : tiles;
    for (int tt = my_first; tt < my_end; tt += my_step) {
        const int t = xcd_order ? (xcd * part_tiles + tt) : tt;
        const int m0 = (t / ntn) * 128, n0 = (t % ntn) * 128;
        f32x4 acc[4][4];
#pragma unroll
        for (int i = 0; i < 4; ++i)
#pragma unroll
            for (int j = 0; j < 4; ++j) acc[i][j] = (f32x4){0.f, 0.f, 0.f, 0.f};
        const bf16_t* ag[4]; const bf16_t* bg[4];
#pragma unroll
        for (int i = 0; i < 4; ++i) {
            const int row = (i * 4 + wave) * 8 + srow, c = spc ^ ((row >> 1) & 7);
            ag[i] = A + (size_t)(m0 + row) * 1024 + c * 8;
            bg[i] = BT + (size_t)(n0 + row) * 1024 + c * 8;
        }
#define GEMM_STAGE(buf, kt) do { _Pragma("unroll") for (int i = 0; i < 4; ++i) { \
            __builtin_amdgcn_global_load_lds((const unsigned*)(ag[i] + (kt) * 64), (unsigned*)(lds + (buf) * 2 * TILE_ELEMS + (i * 4 + wave) * 8 * 64), 16, 0, 0); \
            __builtin_amdgcn_global_load_lds((const unsigned*)(bg[i] + (kt) * 64), (unsigned*)(lds + (buf) * 2 * TILE_ELEMS + TILE_ELEMS + (i * 4 + wave) * 8 * 64), 16, 0, 0); } } while (0)
        __syncthreads();
        GEMM_STAGE(0, 0);
        __syncthreads();
        for (int kt = 0; kt < 16; ++kt) {
            const bf16_t* As = lds + (kt & 1) * 2 * TILE_ELEMS;
            const bf16_t* Bs = As + TILE_ELEMS;
            if (kt + 1 < 16) GEMM_STAGE((kt + 1) & 1, kt + 1);
            bf16x8 af[2][4], bfr[2][4];
#define LDA(ks, i) { const int r = wm * 64 + (i) * 16 + r16; af[ks][i] = *(const bf16x8*)(As + r * 64 + ((((ks) * 4 + q4) ^ ((r >> 1) & 7)) << 3)); }
#define LDB(ks, j) { const int r = wn * 64 + (j) * 16 + r16; bfr[ks][j] = *(const bf16x8*)(Bs + r * 64 + ((((ks) * 4 + q4) ^ ((r >> 1) & 7)) << 3)); }
            LDA(0, 0) LDB(0, 0) LDB(0, 1) LDB(0, 2) LDB(0, 3) LDA(0, 1) LDA(0, 2) LDA(0, 3)
            LDA(1, 0) LDB(1, 0) LDB(1, 1) LDB(1, 2) LDA(1, 1) LDA(1, 2) LDA(1, 3)
            __builtin_amdgcn_sched_barrier(0);
#pragma unroll
            for (int j = 0; j < 4; ++j) acc[0][j] = __builtin_amdgcn_mfma_f32_16x16x32_bf16(bfr[0][j], af[0][0], acc[0][j], 0, 0, 0);
            __builtin_amdgcn_sched_barrier(0);
            LDB(1, 3)
            __builtin_amdgcn_sched_barrier(0);
#pragma unroll
            for (int i = 1; i < 4; ++i)
#pragma unroll
                for (int j = 0; j < 4; ++j) acc[i][j] = __builtin_amdgcn_mfma_f32_16x16x32_bf16(bfr[0][j], af[0][i], acc[i][j], 0, 0, 0);
#pragma unroll
            for (int i = 0; i < 4; ++i)
#pragma unroll
                for (int j = 0; j < 4; ++j) acc[i][j] = __builtin_amdgcn_mfma_f32_16x16x32_bf16(bfr[1][j], af[1][i], acc[i][j], 0, 0, 0);
#undef LDA
#undef LDB
            __builtin_amdgcn_sched_barrier(0);
            __syncthreads();
        }
#undef GEMM_STAGE
        if (EPI == 0) {
            constexpr int CS = 136;
            bf16_t* Cs = lds;
#pragma unroll
            for (int i = 0; i < 4; ++i)
#pragma unroll
                for (int j = 0; j < 4; ++j) {
                    uint2 pk; pk.x = cvt_pk_bf16(acc[i][j][0], acc[i][j][1]); pk.y = cvt_pk_bf16(acc[i][j][2], acc[i][j][3]);
                    *(uint2*)(Cs + (wm * 64 + i * 16 + r16) * CS + wn * 64 + j * 16 + q4 * 4) = pk;
                }
            __syncthreads();
#pragma unroll
            for (int it = 0; it < 8; ++it) {
                const int c = tid + 256 * it, row = c >> 4, cc = c & 15;
                if (n0 + cc * 8 < N) *(u32x4*)(C + (size_t)(m0 + row) * ldc + n0 + cc * 8) = *(const u32x4*)(Cs + row * CS + cc * 8);
            }
        } else if (EPI == 1) {
            constexpr int FS = 132;
            float* Fs = (float*)lds;
            float* SSP = (float*)(p.ws + WS_SSP);
            const float* gn2 = sp_ptr(p, SP_NORM2 + l * D);
#pragma unroll
            for (int i = 0; i < 4; ++i)
#pragma unroll
                for (int j = 0; j < 4; ++j) *(f32x4*)(Fs + (wm * 64 + i * 16 + r16) * FS + wn * 64 + j * 16 + q4 * 4) = acc[i][j];
            __syncthreads();
            const int mr = row_modrow(m0), cc = (tid & 31) * 4, col = n0 + cc;
            const float4 g4v = *(const float4*)(mod_ptr(p, l, mr, 2) + col);
            const float4 s4 = *(const float4*)(mod_ptr(p, l, mr, 4) + col), n4 = *(const float4*)(gn2 + col);
#pragma unroll 4
            for (int it = 0; it < 16; ++it) {
                const int lrow = (tid >> 5) + 8 * it;
                const int row = m0 + lrow;
                float* xr = xrow_ptr(p, row);
                const float* xs = (l == 0) ? xin_ptr(p, row) : xr;
                const f32x4 a4 = *(const f32x4*)(Fs + lrow * FS + cc);
                const float4 x4 = *(const float4*)(xs + col);
                const float4 xn = make_float4(x4.x + g4v.x * a4.x, x4.y + g4v.y * a4.y, x4.z + g4v.z * a4.z, x4.w + g4v.w * a4.w);
                *(float4*)(xr + col) = xn;
                uint2 hp;
                hp.x = cvt_pk_bf16(xn.x * n4.x * (1.f + s4.x), xn.y * n4.y * (1.f + s4.y));
                hp.y = cvt_pk_bf16(xn.z * n4.z * (1.f + s4.z), xn.w * n4.w * (1.f + s4.w));
                *(uint2*)(C + (size_t)row * ldc + col) = hp;
                float ssq = xn.x * xn.x + xn.y * xn.y + xn.z * xn.z + xn.w * xn.w;
                ssq += xor_lane<1>(ssq); ssq += xor_lane<2>(ssq); ssq += xor_lane<4>(ssq); ssq += xor_lane<8>(ssq); ssq += xor_lane<16>(ssq);
                if ((lane & 31) == 0) SSP[(size_t)row * 8 + (n0 >> 7)] = ssq;
            }
        } else if (EPI == 3) {
            qgemm_topk_epilogue(p, l, m0, n0, acc, smem);
        } else {
            constexpr int CS = 136;
            bf16_t* Cs = lds;
            float* rsv = (float*)(lds + 128 * CS);
            const float* SSP = (const float*)(p.ws + WS_SSP);
            const float* BQ = (const float*)(p.ws + WS_BQ) + (size_t)l * 9 * 2048;
            if (tid < 128) {
                const f32x4* sp4 = (const f32x4*)(SSP + (size_t)(m0 + tid) * 8);
                const f32x4 a = sp4[0], b = sp4[1];
                const float ss = ((a.x + a.y) + (a.z + a.w)) + ((b.x + b.y) + (b.z + b.w));
                rsv[tid] = rsqrtf(ss * (1.f / 1024.f) + 1e-6f);
            }
            __syncthreads();
#pragma unroll
            for (int i = 0; i < 4; ++i) {
                const int lrow = wm * 64 + i * 16 + r16;
                const float rs = rsv[lrow];
                const float* bq = BQ + (size_t)row_modrow(m0 + lrow) * 2048 + n0 + wn * 64 + q4 * 4;
#pragma unroll
                for (int j = 0; j < 4; ++j) {
                    const float4 b4 = *(const float4*)(bq + j * 16);
                    uint2 pk;
                    pk.x = cvt_pk_bf16(rs * acc[i][j][0] + b4.x, rs * acc[i][j][1] + b4.y);
                    pk.y = cvt_pk_bf16(rs * acc[i][j][2] + b4.z, rs * acc[i][j][3] + b4.w);
                    *(uint2*)(Cs + lrow * CS + wn * 64 + j * 16 + q4 * 4) = pk;
                }
            }
            __syncthreads();
#pragma unroll
            for (int it = 0; it < 8; ++it) {
                const int c = tid + 256 * it, row = c >> 4, cc = c & 15;
                *(u32x4*)(C + (size_t)(m0 + row) * ldc + n0 + cc * 8) = *(const u32x4*)(Cs + row * CS + cc * 8);
            }
        }
    }
}

DEVI void gdn_chunk_rows(int b, int dir, int np, int& row0, int& s0, int& L, int& seqbase) {
    if (np < 4) { const int tb = dir ? 3 - np : np; seqbase = NX + b * LC; s0 = tb * 64; L = LC; }
    else { const int tb = dir ? 31 - (np - 4) : (np - 4); seqbase = b * SEQ; s0 = tb * 64; L = SEQ; }
    row0 = seqbase + s0;
}
DEVI int kperm_pos(int k) { return ((k >> 5) << 5) + (((k >> 2) & 3) << 3) + (((k >> 4) & 1) << 2) + (k & 3); }

DEVI float wave_reduce16(const float (&s)[16], int lane) {
    float t8[8], t4[4], t2[2], tot;
#pragma unroll
    for (int i = 0; i < 8; ++i) { const float mine = (lane & 1) ? s[2 * i + 1] : s[2 * i], other = (lane & 1) ? s[2 * i] : s[2 * i + 1]; t8[i] = mine + xor_lane<1>(other); }
#pragma unroll
    for (int i = 0; i < 4; ++i) { const float mine = (lane & 2) ? t8[2 * i + 1] : t8[2 * i], other = (lane & 2) ? t8[2 * i] : t8[2 * i + 1]; t4[i] = mine + xor_lane<2>(other); }
#pragma unroll
    for (int i = 0; i < 2; ++i) { const float mine = (lane & 4) ? t4[2 * i + 1] : t4[2 * i], other = (lane & 4) ? t4[2 * i] : t4[2 * i + 1]; t2[i] = mine + xor_lane<4>(other); }
    { const float mine = (lane & 8) ? t2[1] : t2[0], other = (lane & 8) ? t2[0] : t2[1]; tot = mine + xor_lane<8>(other); }
    tot += xor_lane<16>(tot); tot += xor_lane<32>(tot);
    return tot;
}
DEVI float readlane_f(float v, int l) { return __uint_as_float((unsigned)__builtin_amdgcn_readlane((int)__float_as_uint(v), l)); }

DEVI void gdn_local_task(const Params& p, int l, int chain, int np, unsigned char* smem, int inv_rot) {
    const int tid = tidx(), lane = tid & 63, wave = tid >> 6, r16 = lane & 15, g4 = lane >> 4;
    const int b = chain / 12, h = (chain % 12) >> 1, dir = chain & 1;
    int row0, s0, L, seqbase; gdn_chunk_rows(b, dir, np, row0, s0, L, seqbase);
    const bf16_t* P = (const bf16_t*)(p.ws + WS_P);
    unsigned char* chb = p.ws + WS_CH + ((size_t)chain * 36 + np) * CH_TASK_BYTES;
    bf16_t* qs = (bf16_t*)smem;
    bf16_t* ks = qs + 64 * 72;
    bf16_t* vs = ks + 64 * 72;
    float* Ld = (float*)(smem + 27648);
    bf16_t* als = (bf16_t*)(smem + 32768);
    float* Rm = (float*)(smem + 32768);
    float* gcs = (float*)(smem + 41984);
    float* betas = gcs + 64; float* egc = betas + 64; float* ekd = egc + 64;
    bf16_t* Lb = (bf16_t*)(smem + 43008);
    bf16_t* XT = (bf16_t*)(smem + 52224);
    bf16_t* raw = (bf16_t*)(smem + 43008);
    u32x4 rv[7];
    const int c8s = tid & 7, rbs = tid >> 3;
    {
        const bf16_t* pb = P + (size_t)(seqbase + s0 - 2 + rbs) * INW + C_GQKV + h * 64 + c8s * 8;
        const int sA = s0 - 2 + rbs, sB = sA + 32;
        const bool okA = sA >= 0 && sA < L, okB = sB >= 0 && sB < L;
#pragma unroll
        for (int mat = 0; mat < 3; ++mat) {
            rv[2 * mat] = okA ? *(const u32x4*)(pb + mat * 384) : (u32x4){0u, 0u, 0u, 0u};
            rv[2 * mat + 1] = okB ? *(const u32x4*)(pb + (size_t)32 * INW + mat * 384) : (u32x4){0u, 0u, 0u, 0u};
        }
        const int mat6 = tid >> 5, rr6 = 64 + ((tid >> 3) & 3), s6 = s0 - 2 + rr6;
        rv[6] = (tid < 96 && s6 >= 0 && s6 < L) ? *(const u32x4*)(P + (size_t)(seqbase + s6) * INW + C_GQKV + mat6 * 384 + h * 64 + c8s * 8) : (u32x4){0u, 0u, 0u, 0u};
    }
    __syncthreads();
    if (wave == 0) {
        const int ti = dir ? 63 - lane : lane;
        const bf16_t* pr = P + (size_t)(row0 + ti) * INW + C_GBA;
        const float braw = bf2f(pr[dir * 6 + h]), araw = bf2f(pr[12 + dir * 6 + h]);
        const float beta = sigmoid_f(braw);
        float gc = -__expf(sp_ptr(p, SP_ALOG)[l * 12 + dir * 6 + h]) * softplus_f(araw + sp_ptr(p, SP_DTB)[l * 12 + dir * 6 + h]);
#pragma unroll
        for (int off = 1; off < 64; off <<= 1) { const float t = __shfl_up(gc, off); if (lane >= off) gc += t; }
        const float gl = __shfl(gc, 63);
        gcs[lane] = gc; betas[lane] = beta; egc[lane] = __expf(gc); ekd[lane] = __expf(gl - gc);
        if (lane == 63) ((float*)(p.ws + WS_GL))[chain * 36 + np] = __expf(gc);
    }
#pragma unroll
    for (int mat = 0; mat < 3; ++mat) {
        *(u32x4*)(raw + (mat * 68 + rbs) * 64 + c8s * 8) = rv[2 * mat];
        *(u32x4*)(raw + (mat * 68 + rbs + 32) * 64 + c8s * 8) = rv[2 * mat + 1];
    }
    if (tid < 96) *(u32x4*)(raw + ((tid >> 5) * 68 + 64 + ((tid >> 3) & 3)) * 64 + c8s * 8) = rv[6];
    __syncthreads();
    {
        const int d = lane, tq = wave;
        const float* cw = sp_ptr(p, SP_CONVW + l * 5 * 1152);
#pragma unroll 1
        for (int mat = 0; mat < 3; ++mat) {
            const int ch = mat * 384 + h * 64 + d;
            float w[5];
#pragma unroll
            for (int tap = 0; tap < 5; ++tap) w[tap] = cw[tap * 1152 + ch];
            float x[20];
#pragma unroll
            for (int tt = 0; tt < 20; ++tt) x[tt] = bf2f(raw[(mat * 68 + tq * 16 + tt) * 64 + d]);
            float y[16], sq[16];
#pragma unroll
            for (int t = 0; t < 16; t += 2) {
                const f32x2 c2 = (f32x2){w[0] * x[t] + w[1] * x[t + 1] + w[2] * x[t + 2] + w[3] * x[t + 3] + w[4] * x[t + 4],
                                         w[0] * x[t + 1] + w[1] * x[t + 2] + w[2] * x[t + 3] + w[3] * x[t + 4] + w[4] * x[t + 5]};
                const f32x2 z2 = c2 * (f32x2){-1.4426950408889634f, -1.4426950408889634f};
                const f32x2 e2 = (f32x2){__builtin_amdgcn_exp2f(z2.x), __builtin_amdgcn_exp2f(z2.y)} + (f32x2){1.f, 1.f};
                const f32x2 y2 = c2 * (f32x2){__builtin_amdgcn_rcpf(e2.x), __builtin_amdgcn_rcpf(e2.y)};
                const f32x2 s2 = y2 * y2;
                y[t] = y2.x; y[t + 1] = y2.y; sq[t] = s2.x; sq[t + 1] = s2.y;
            }
            bf16_t* dst = (mat == 0) ? qs : ((mat == 1) ? ks : vs);
            float rsn = 1.f;
            if (mat < 2) rsn = rsqrtf(wave_reduce16(sq, lane) + 1e-6f);
#pragma unroll
            for (int t = 0; t < 16; ++t) {
                const float f = (mat < 2) ? readlane_f(rsn, t) : 1.f;
                const int tok = tq * 16 + t, i = dir ? 63 - tok : tok;
                dst[i * 72 + d] = f2bf(y[t] * f);
            }
        }
    }
    __syncthreads();
    for (int i = tid; i < 18432 / 16; i += NT) ((u32x4*)XT)[i] = (u32x4){0u, 0u, 0u, 0u};
    {
        bf16x8 ak[2], aq[2];
#pragma unroll
        for (int kk = 0; kk < 2; ++kk) {
            ak[kk] = *(const bf16x8*)(ks + (wave * 16 + r16) * 72 + kk * 32 + g4 * 8);
            aq[kk] = *(const bf16x8*)(qs + (wave * 16 + r16) * 72 + kk * 32 + g4 * 8);
        }
        const int wave_u = __builtin_amdgcn_readfirstlane(wave);
        float gci[4], bti[4];
#pragma unroll
        for (int r = 0; r < 4; ++r) { gci[r] = gcs[wave * 16 + g4 * 4 + r]; bti[r] = betas[wave * 16 + g4 * 4 + r]; }
#pragma unroll
        for (int tj = 0; tj < 4; ++tj) {
            if (tj > wave_u) {
                const int zr = wave * 16 + (lane >> 2), zc = tj * 16 + (lane & 3) * 4;
                *(uint2*)(Lb + zr * 72 + zc) = make_uint2(0u, 0u);
                *(uint2*)(als + zr * 72 + zc) = make_uint2(0u, 0u);
                continue;
            }
            f32x4 ckk = (f32x4){0.f, 0.f, 0.f, 0.f}, cqk = (f32x4){0.f, 0.f, 0.f, 0.f};
#pragma unroll
            for (int kk = 0; kk < 2; ++kk) {
                const bf16x8 bk = *(const bf16x8*)(ks + (tj * 16 + r16) * 72 + kk * 32 + g4 * 8);
                ckk = __builtin_amdgcn_mfma_f32_16x16x32_bf16(ak[kk], bk, ckk, 0, 0, 0);
                cqk = __builtin_amdgcn_mfma_f32_16x16x32_bf16(aq[kk], bk, cqk, 0, 0, 0);
            }
            const int j = tj * 16 + r16;
            const float gcj = gcs[j];
            if (tj == wave_u) {
#pragma unroll
                for (int r = 0; r < 4; ++r) {
                    const int i = wave * 16 + g4 * 4 + r;
                    const float dec = __expf((j <= i) ? (gci[r] - gcj) : 0.f);
                    const float lv = (j < i) ? bti[r] * ckk[r] * dec : 0.f;
                    Lb[i * 72 + j] = f2bf(lv);
                    Ld[(wave * 16 + g4 * 4 + r) * 20 + r16] = lv;
                    als[i * 72 + j] = f2bf((j <= i) ? cqk[r] * 0.125f * dec : 0.f);
                }
            } else {
#pragma unroll
                for (int r = 0; r < 4; ++r) {
                    const int i = wave * 16 + g4 * 4 + r;
                    const float dec = __expf(gci[r] - gcj);
                    Lb[i * 72 + j] = f2bf(bti[r] * ckk[r] * dec);
                    als[i * 72 + j] = f2bf(cqk[r] * 0.125f * dec);
                }
            }
        }
    }
    __syncthreads();
    const int wv_u = __builtin_amdgcn_readfirstlane(wave), inv_w = inv_rot & 3;
    if (wv_u != inv_w) {
        const int idx3 = (wv_u - (wv_u > inv_w ? 1 : 0)) * 64 + lane;
#pragma unroll
        for (int it = 0; it < 3; ++it) {
            const int cc = idx3 + 192 * it;
            if (cc >= 512) break;
            const int m = cc >> 3, kc = cc & 7, kss = kc >> 2, gg = kc & 3;
            const int k0 = kss * 32 + gg * 4, k1 = k0 + 16;
            {
                const uint2 a = *(const uint2*)(als + m * 72 + k0), bq = *(const uint2*)(als + m * 72 + k1);
                u32x4 o; o.x = a.x; o.y = a.y; o.z = bq.x; o.w = bq.y;
                *(u32x4*)(chb + 2 * 8192 + cc * 16) = o;
            }
            {
                const float sc = 0.125f * egc[m];
                const uint2 a = *(const uint2*)(qs + m * 72 + k0), bq = *(const uint2*)(qs + m * 72 + k1);
                u32x4 o;
                o.x = cvt_pk_bf16(lo_f(a.x) * sc, hi_f(a.x) * sc); o.y = cvt_pk_bf16(lo_f(a.y) * sc, hi_f(a.y) * sc);
                o.z = cvt_pk_bf16(lo_f(bq.x) * sc, hi_f(bq.x) * sc); o.w = cvt_pk_bf16(lo_f(bq.y) * sc, hi_f(bq.y) * sc);
                *(u32x4*)(chb + 1 * 8192 + cc * 16) = o;
            }
            {
                float v[8];
                const f32x4 ek0 = *(const f32x4*)(ekd + k0), ek1 = *(const f32x4*)(ekd + k1);
#pragma unroll
                for (int jj = 0; jj < 4; ++jj) { v[jj] = bf2f(ks[(k0 + jj) * 72 + m]) * ek0[jj]; v[4 + jj] = bf2f(ks[(k1 + jj) * 72 + m]) * ek1[jj]; }
                u32x4 o; o.x = cvt_pk_bf16(v[0], v[1]); o.y = cvt_pk_bf16(v[2], v[3]); o.z = cvt_pk_bf16(v[4], v[5]); o.w = cvt_pk_bf16(v[6], v[7]);
                *(u32x4*)(chb + 3 * 8192 + cc * 16) = o;
            }
        }
    }
    if (wv_u == inv_w) {
        float lrow[16];
        {
            const f32x4* lp = (const f32x4*)(Ld + (g4 * 16 + r16) * 20);
#pragma unroll
            for (int q = 0; q < 4; ++q) { const f32x4 v = lp[q]; lrow[4 * q] = v.x; lrow[4 * q + 1] = v.y; lrow[4 * q + 2] = v.z; lrow[4 * q + 3] = v.w; }
        }
        const int c = r16;
        float x[16];
#pragma unroll
        for (int ii = 0; ii < 16; ++ii) {
            float a0 = (ii == c) ? 1.f : 0.f, a1 = 0.f;
#pragma unroll
            for (int jj = 0; jj < ii; ++jj) { const float lv = row_share_f(lrow[jj], ii); if (jj & 1) a1 -= lv * x[jj]; else a0 -= lv * x[jj]; }
            x[ii] = a0 + a1;
        }
        __builtin_amdgcn_wave_barrier();
#pragma unroll
        for (int ii = 0; ii < 16; ++ii) Ld[(g4 * 16 + ii) * 20 + c] = x[ii];
    }
    __syncthreads();
#pragma unroll 1
    for (int bb = 0; bb < 4; ++bb) {
#pragma unroll
        for (int q = 0; q < 2; ++q) {
            const int nt = wave * 2 + q;
            f32x4 acc = (f32x4){0.f, 0.f, 0.f, 0.f};
            if (bb > 0) {
                const bf16x8 a0 = *(const bf16x8*)(Lb + (bb * 16 + r16) * 72 + g4 * 8);
                const bf16x8 b0 = *(const bf16x8*)(XT + (nt * 16 + r16) * 72 + g4 * 8);
                acc = __builtin_amdgcn_mfma_f32_16x16x32_bf16(a0, b0, acc, 0, 0, 0);
                if (bb == 3) {
                    const bf16x8 a1 = *(const bf16x8*)(Lb + (bb * 16 + r16) * 72 + 32 + g4 * 8);
                    const bf16x8 b1 = *(const bf16x8*)(XT + (nt * 16 + r16) * 72 + 32 + g4 * 8);
                    acc = __builtin_amdgcn_mfma_f32_16x16x32_bf16(a1, b1, acc, 0, 0, 0);
                }
            }
            const bool isw = nt >= 4;
            const bf16_t* src = isw ? ks : vs;
            const int cc = (nt & 3) * 16 + r16;
            float rh[4], nv[4];
            {
                const f32x4 b4 = *(const f32x4*)(betas + bb * 16 + 4 * g4), e4 = *(const f32x4*)(egc + bb * 16 + 4 * g4);
                const f32x4 n4 = *(const f32x4*)(Ld + (bb * 16 + r16) * 20 + 4 * g4);
                const f32x4 sc4 = isw ? b4 * e4 : b4;
#pragma unroll
                for (int kb = 0; kb < 4; ++kb) {
                    const int i = bb * 16 + 4 * g4 + kb;
                    rh[kb] = bf2f(src[i * 72 + cc]) * sc4[kb] - acc[kb];
                    nv[kb] = n4[kb];
                }
            }
            f32x4 xa = (f32x4){0.f, 0.f, 0.f, 0.f};
#pragma unroll
            for (int kb = 0; kb < 4; ++kb) xa = __builtin_amdgcn_mfma_f32_16x16x4f32(nv[kb], rh[kb], xa, 0, 0, 0);
            {
                uint2 pk; pk.x = cvt_pk_bf16(xa[0], xa[1]); pk.y = cvt_pk_bf16(xa[2], xa[3]);
                *(uint2*)(XT + (nt * 16 + r16) * 72 + bb * 16 + 4 * g4) = pk;
            }
        }
    }
    __syncthreads();
    {
#pragma unroll
        for (int it = 0; it < 2; ++it) {
            const int cc = tid + 256 * it, m = cc >> 3, kc = cc & 7, kss = kc >> 2, gg = kc & 3;
            const int k0 = kss * 32 + gg * 4, k1 = k0 + 16;
            *(u32x4*)(chb + 4 * 8192 + cc * 16) = *(const u32x4*)(XT + m * 72 + kc * 8);
            float v[8];
#pragma unroll
            for (int jj = 0; jj < 4; ++jj) { v[jj] = -bf2f(XT[(64 + k0 + jj) * 72 + m]); v[4 + jj] = -bf2f(XT[(64 + k1 + jj) * 72 + m]); }
            u32x4 o; o.x = cvt_pk_bf16(v[0], v[1]); o.y = cvt_pk_bf16(v[2], v[3]); o.z = cvt_pk_bf16(v[4], v[5]); o.w = cvt_pk_bf16(v[6], v[7]);
            *(u32x4*)(chb + 0 * 8192 + cc * 16) = o;
        }
    }
}

DEVI void pool_task(const Params& p, int l, int t0row, unsigned char* smem) {
    const int tid = tidx();
    float* a = (float*)smem;
    const bf16_t* P = (const bf16_t*)(p.ws + WS_P);
    bf16_t* Y = (bf16_t*)(p.ws + WS_Y);
    int s0, L, base;
    if (t0row < NX) { s0 = t0row & 2047; L = SEQ; base = t0row - s0; } else { s0 = (t0row - NX) & 255; L = LC; base = t0row - s0; }
    bf16x8 wf[4][2];
    {
        const int lane = tid & 63, gi = tid >> 6, r16 = lane & 15, g4 = lane >> 4;
        const bf16_t* wt = (const bf16_t*)sp_ptr(p, SP_WPOOL) + (size_t)((l * 4 + gi) * 64) * 64;
#pragma unroll
        for (int nt = 0; nt < 4; ++nt)
#pragma unroll
            for (int ks = 0; ks < 2; ++ks) wf[nt][ks] = *(const bf16x8*)(wt + (nt * 16 + r16) * 64 + ks * 32 + g4 * 8);
    }
    __syncthreads();
#pragma unroll
    for (int it = 0; it < 4; ++it) {
        const int c = tid + 256 * it, rr = c >> 5, cc = (c & 31) * 8;
        const int s = s0 - 8 + rr;
        uint4 v = make_uint4(0u, 0u, 0u, 0u);
        if (s >= 0 && s < L) v = *(const uint4*)(P + (size_t)(base + s) * INW + C_POOL + cc);
        float* dst = a + rr * 256 + cc;
        dst[0] = lo_f(v.x); dst[1] = hi_f(v.x); dst[2] = lo_f(v.y); dst[3] = hi_f(v.y);
        dst[4] = lo_f(v.z); dst[5] = hi_f(v.z); dst[6] = lo_f(v.w); dst[7] = hi_f(v.w);
    }
    __syncthreads();
    bf16_t* Pb = (bf16_t*)(smem + 32768);
    bf16_t* Ys = Pb + 16 * 264;
    {
        const int ch = tid, gi = ch >> 6, hw = 1 << gi;
        float sum = 0.f;
#pragma unroll
        for (int k = -8; k < 8; ++k) { const float v = a[(8 + k) * 256 + ch]; sum += (k >= -hw && k < hw) ? v : 0.f; }
        const float* ain = a + (8 + hw) * 256 + ch;
        const float* aout = a + (8 - hw) * 256 + ch;
#pragma unroll
        for (int tok = 0; tok < 16; ++tok) {
            const int s = s0 + tok;
            int lo = s - hw; if (lo < 0) lo = 0;
            int hi = s + hw; if (hi > L) hi = L;
            Pb[tok * 264 + ch] = f2bf(sum * __builtin_amdgcn_rcpf((float)(hi - lo)) - a[(tok + 8) * 256 + ch]);
            sum += ain[tok * 256] - aout[tok * 256];
        }
    }
    __syncthreads();
    {
        const int lane = tid & 63, gi = tid >> 6, r16 = lane & 15, g4 = lane >> 4;
        bf16x8 af[2];
#pragma unroll
        for (int ks = 0; ks < 2; ++ks) af[ks] = *(const bf16x8*)(Pb + r16 * 264 + gi * 64 + ks * 32 + g4 * 8);
        const float* ps = sp_ptr(p, SP_PSCALE) + l * 256 + gi * 64;
#pragma unroll
        for (int nt = 0; nt < 4; ++nt) {
            f32x4 acc = (f32x4){0.f, 0.f, 0.f, 0.f};
#pragma unroll
            for (int ks = 0; ks < 2; ++ks) acc = __builtin_amdgcn_mfma_f32_16x16x32_bf16(af[ks], wf[nt][ks], acc, 0, 0, 0);
            const float sc = ps[nt * 16 + r16];
#pragma unroll
            for (int r = 0; r < 4; ++r) Ys[(g4 * 4 + r) * 264 + gi * 64 + nt * 16 + r16] = f2bf(acc[r] * sc);
        }
    }
    __syncthreads();
#pragma unroll
    for (int it = 0; it < 2; ++it) {
        const int c = tid + 256 * it, tok = c >> 5, cc = c & 31;
        *(u32x4*)(Y + (size_t)(t0row + tok) * D + cc * 8) = *(const u32x4*)(Ys + tok * 264 + cc * 8);
    }
}

DEVI void attn_task(const Params& p, int l, int qrow0, int qh, bool is_x, int b, int n, unsigned char* smem) {
    const int tid = tidx(), lane = tid & 63, wave = tid >> 6, r16 = lane & 15, g4 = lane >> 4;
    const bf16_t* P = (const bf16_t*)(p.ws + WS_P);
    bf16_t* Y = (bf16_t*)(p.ws + WS_Y);
    const float* rc = (const float*)(p.ws + WS_ROPE); const float* rsn = rc + 2048 * 32;
    bf16_t* Ksm = (bf16_t*)smem;
    bf16_t* Vt = Ksm + 64 * 72;
    const int hk = qh / 3;
    bf16x8 qf[2][2];
#pragma unroll
    for (int mt = 0; mt < 2; ++mt) {
        const int row = qrow0 + wave * 32 + mt * 16 + r16;
#pragma unroll
        for (int ks = 0; ks < 2; ++ks) {
            const u32x4 raw = *(const u32x4*)(P + (size_t)row * INW + C_AQ + qh * 64 + ks * 32 + g4 * 8);
            float x[8] = {lo_f(raw.x), hi_f(raw.x), lo_f(raw.y), hi_f(raw.y), lo_f(raw.z), hi_f(raw.z), lo_f(raw.w), hi_f(raw.w)};
            if (is_x) {
                const int s = row & 2047;
                const u32x4 raw2 = *(const u32x4*)(P + (size_t)row * INW + C_AQ + qh * 64 + ks * 32 + (g4 ^ 2) * 8);
                const float x2v[8] = {lo_f(raw2.x), hi_f(raw2.x), lo_f(raw2.y), hi_f(raw2.y), lo_f(raw2.z), hi_f(raw2.z), lo_f(raw2.w), hi_f(raw2.w)};
                const float4* c4 = (const float4*)(rc + s * 32 + ks * 16 + (g4 & 1) * 8);
                const float4* s4 = (const float4*)(rsn + s * 32 + ks * 16 + (g4 & 1) * 8);
                const float4 ca = c4[0], cb = c4[1], sa4 = s4[0], sb4 = s4[1];
                const float cv[8] = {ca.x, ca.y, ca.z, ca.w, cb.x, cb.y, cb.z, cb.w};
                const float sv[8] = {sa4.x, sa4.y, sa4.z, sa4.w, sb4.x, sb4.y, sb4.z, sb4.w};
#pragma unroll
                for (int j = 0; j < 8; ++j) {
                    const float other = x2v[j];
                    x[j] = (g4 < 2) ? (x[j] * cv[j] - other * sv[j]) : (x[j] * cv[j] + other * sv[j]);
                }
            }
            u32x4 pk;
            constexpr float QS = 0.125f * 1.4426950408889634f;
            pk.x = cvt_pk_bf16(x[0] * QS, x[1] * QS); pk.y = cvt_pk_bf16(x[2] * QS, x[3] * QS);
            pk.z = cvt_pk_bf16(x[4] * QS, x[5] * QS); pk.w = cvt_pk_bf16(x[6] * QS, x[7] * QS);
            qf[mt][ks] = __builtin_bit_cast(bf16x8, pk);
        }
    }
    f32x4 O[2][4];
#pragma unroll
    for (int mt = 0; mt < 2; ++mt)
#pragma unroll
        for (int dt = 0; dt < 4; ++dt) O[mt][dt] = (f32x4){0.f, 0.f, 0.f, 0.f};
    const float sinkv = sp_ptr(p, SP_SINK)[l * 6 + qh] * 1.4426950408889634f;
    float mrow[2] = {sinkv, sinkv};
    float lpart[2] = {g4 == 0 ? 1.f : 0.f, g4 == 0 ? 1.f : 0.f};
    for (int sg = (is_x ? 0 : 3); sg < 5; ++sg) {
        if (sg == 0 && n == 0) continue;
        if (sg == 2 && n == 15) continue;
        const int krow0 = (sg < 3) ? (b * SEQ + (n - 1 + sg) * 128) : (NX + b * LC + (sg - 3) * 128);
        const int mtype = (sg < 3) ? 1 : 0;
        const int krope = (sg < 3) ? 1 : 0;
        for (int sub = 0; sub < 2; ++sub) {
            __syncthreads();
            {
                const int key = tid >> 2, a = (tid >> 1) & 1, ph = tid & 1;
                const int krow = krow0 + sub * 64 + key;
                const bf16_t* kp = P + (size_t)krow * INW + C_AK + hk * 64 + a * 32 + ph * 8;
                const bf16_t* vp = P + (size_t)krow * INW + C_AV + hk * 64 + a * 32 + ph * 8;
                const u32x4 k1 = *(const u32x4*)kp, k2 = *(const u32x4*)(kp + 16);
                const u32x4 v1 = *(const u32x4*)vp, v2 = *(const u32x4*)(vp + 16);
                float x1[8] = {lo_f(k1.x), hi_f(k1.x), lo_f(k1.y), hi_f(k1.y), lo_f(k1.z), hi_f(k1.z), lo_f(k1.w), hi_f(k1.w)};
                float x2[8] = {lo_f(k2.x), hi_f(k2.x), lo_f(k2.y), hi_f(k2.y), lo_f(k2.z), hi_f(k2.z), lo_f(k2.w), hi_f(k2.w)};
                if (krope) {
                    const int s = krow & 2047;
                    const float4* c4 = (const float4*)(rc + s * 32 + a * 16 + ph * 8);
                    const float4* s4 = (const float4*)(rsn + s * 32 + a * 16 + ph * 8);
                    const float4 ca = c4[0], cb = c4[1], sa4 = s4[0], sb4 = s4[1];
                    const float cv[8] = {ca.x, ca.y, ca.z, ca.w, cb.x, cb.y, cb.z, cb.w};
                    const float sv[8] = {sa4.x, sa4.y, sa4.z, sa4.w, sb4.x, sb4.y, sb4.z, sb4.w};
#pragma unroll
                    for (int j = 0; j < 8; ++j) {
                        const float y1 = x1[j] * cv[j] - x2[j] * sv[j], y2 = x2[j] * cv[j] + x1[j] * sv[j];
                        x1[j] = y1; x2[j] = y2;
                    }
                }
                u32x4 o1, o2;
                o1.x = cvt_pk_bf16(x1[0], x1[1]); o1.y = cvt_pk_bf16(x1[2], x1[3]); o1.z = cvt_pk_bf16(x1[4], x1[5]); o1.w = cvt_pk_bf16(x1[6], x1[7]);
                o2.x = cvt_pk_bf16(x2[0], x2[1]); o2.y = cvt_pk_bf16(x2[2], x2[3]); o2.z = cvt_pk_bf16(x2[4], x2[5]); o2.w = cvt_pk_bf16(x2[6], x2[7]);
                *(u32x4*)(Ksm + key * 72 + a * 32 + ph * 8) = o1;
                *(u32x4*)(Ksm + key * 72 + a * 32 + 16 + ph * 8) = o2;
                const int kp2 = kperm_pos(key);
                const unsigned vv[8] = {v1.x, v1.y, v1.z, v1.w, v2.x, v2.y, v2.z, v2.w};
#pragma unroll
                for (int j = 0; j < 4; ++j) {
                    const int d0 = a * 32 + ph * 8 + 2 * j;
                    Vt[(d0) * 72 + kp2] = (bf16_t)(vv[j] & 0xffffu);
                    Vt[(d0 + 1) * 72 + kp2] = (bf16_t)(vv[j] >> 16);
                    Vt[(d0 + 16) * 72 + kp2] = (bf16_t)(vv[4 + j] & 0xffffu);
                    Vt[(d0 + 17) * 72 + kp2] = (bf16_t)(vv[4 + j] >> 16);
                }
            }
            __syncthreads();
            bf16x8 kf[4][2];
#pragma unroll
            for (int kt = 0; kt < 4; ++kt)
#pragma unroll
                for (int ks = 0; ks < 2; ++ks) kf[kt][ks] = *(const bf16x8*)(Ksm + (kt * 16 + r16) * 72 + ks * 32 + g4 * 8);
#pragma unroll
            for (int mt = 0; mt < 2; ++mt) {
                f32x4 st[4];
#pragma unroll
                for (int kt = 0; kt < 4; ++kt) {
                    st[kt] = (f32x4){0.f, 0.f, 0.f, 0.f};
#pragma unroll
                    for (int ks = 0; ks < 2; ++ks) st[kt] = __builtin_amdgcn_mfma_f32_16x16x32_bf16(kf[kt][ks], qf[mt][ks], st[kt], 0, 0, 0);
                }
                const int qi = wave * 32 + mt * 16 + r16;
                float mx = mrow[mt];
                if (sg == 0 || sg == 2) {
#pragma unroll
                    for (int kt = 0; kt < 4; ++kt)
#pragma unroll
                        for (int r = 0; r < 4; ++r) {
                            const int kpos = krow0 + sub * 64 + kt * 16 + g4 * 4 + r;
                            const int dpos = kpos - (qrow0 + qi);
                            const bool valid = (dpos <= 128 && dpos >= -128);
                            st[kt][r] = valid ? st[kt][r] : -1e30f;
                        }
                }
#pragma unroll
                for (int kt = 0; kt < 4; ++kt)
#pragma unroll
                    for (int r = 0; r < 4; ++r) mx = fmaxf(mx, st[kt][r]);
                mx = fmaxf(mx, xor_lane<16>(mx)); mx = fmaxf(mx, xor_lane<32>(mx));
                const float alpha = __builtin_amdgcn_exp2f(mrow[mt] - mx);
                mrow[mt] = mx;
                float psum = 0.f;
#pragma unroll
                for (int kt = 0; kt < 4; ++kt)
#pragma unroll
                    for (int r = 0; r < 4; ++r) { st[kt][r] = __builtin_amdgcn_exp2f(st[kt][r] - mx); psum += st[kt][r]; }
                lpart[mt] = lpart[mt] * alpha + psum;
                bf16x8 pf[2];
#pragma unroll
                for (int ks = 0; ks < 2; ++ks) {
                    u32x4 pk;
                    pk.x = cvt_pk_bf16(st[2 * ks][0], st[2 * ks][1]); pk.y = cvt_pk_bf16(st[2 * ks][2], st[2 * ks][3]);
                    pk.z = cvt_pk_bf16(st[2 * ks + 1][0], st[2 * ks + 1][1]); pk.w = cvt_pk_bf16(st[2 * ks + 1][2], st[2 * ks + 1][3]);
                    pf[ks] = __builtin_bit_cast(bf16x8, pk);
                }
                float ar[4];
#pragma unroll
                for (int r = 0; r < 4; ++r) ar[r] = __shfl(alpha, g4 * 4 + r);
#pragma unroll
                for (int dt = 0; dt < 4; ++dt) {
                    f32x4 o = O[mt][dt];
                    o[0] *= ar[0]; o[1] *= ar[1]; o[2] *= ar[2]; o[3] *= ar[3];
#pragma unroll
                    for (int ks = 0; ks < 2; ++ks) {
                        const bf16x8 vf = *(const bf16x8*)(Vt + (dt * 16 + r16) * 72 + ks * 32 + g4 * 8);
                        o = __builtin_amdgcn_mfma_f32_16x16x32_bf16(pf[ks], vf, o, 0, 0, 0);
                    }
                    O[mt][dt] = o;
                }
            }
        }
    }
#pragma unroll
    for (int mt = 0; mt < 2; ++mt) {
        float lt = lpart[mt];
        lt += xor_lane<16>(lt); lt += xor_lane<32>(lt);
        const float inv = 1.f / lt;
#pragma unroll
        for (int r = 0; r < 4; ++r) {
            const float ir = __shfl(inv, g4 * 4 + r);
            const int row = qrow0 + wave * 32 + mt * 16 + g4 * 4 + r;
#pragma unroll
            for (int dt = 0; dt < 4; ++dt) Y[(size_t)row * D + 640 + qh * 64 + dt * 16 + r16] = f2bf(O[mt][dt][r] * ir);
        }
    }
}

DEVI void mix_task(const Params& p, int l, int u, int n_pool, unsigned char* smem) {
    const int n_attx = NB * 16 * 6;
    if (u < n_pool) { pool_task(p, l, u * 16, smem); return; }
    u -= n_pool;
    if (u < n_attx) { const int b = u / 96, n = (u % 96) / 6, qh = u % 6; attn_task(p, l, b * SEQ + n * 128, qh, true, b, n, smem); return; }
    u -= n_attx;
    { const int b = u / 12, qb = (u % 12) / 6, qh = u % 6; attn_task(p, l, NX + b * LC + qb * 128, qh, false, b, 1, smem); }
}
DEVI void phase_mix1(const Params& p, int l, unsigned char* smem) {
    int part = 0, round = 0;
    for (int t = blockIdx.x; t < 96 * 36; t += gridDim.x, ++round) {
        gdn_local_task(p, l, t / 36, t % 36, smem, round);
        if (l == 0 && part < 8) {
            cvt_fp6_job(p.in[I_PU], p.ws + WS_UB, (size_t)2 * NEXP * 1024, 64.f, part, 8);
            cvt_fp6_job(p.in[I_PV], p.ws + WS_UB + 768, (size_t)2 * NEXP * 1024, 2.f, part, 8);
            ++part;
        }
    }
    if (l == 0) {
        for (; part < 8; ++part) {
            cvt_fp6_job(p.in[I_PU], p.ws + WS_UB, (size_t)2 * NEXP * 1024, 64.f, part, 8);
            cvt_fp6_job(p.in[I_PV], p.ws + WS_UB + 768, (size_t)2 * NEXP * 1024, 2.f, part, 8);
        }
    }
}

DEVI void phase_gdn_scan_chains(const Params& p, unsigned char* smem) {
    const int tid = tidx(), lane = tid & 63, wave = tid >> 6, r16 = lane & 15, g4 = lane >> 4;
    bf16_t* GO = (bf16_t*)(p.ws + WS_GO);
    const float* GL = (const float*)(p.ws + WS_GL);
    for (int chain = blockIdx.x; chain < 96; chain += gridDim.x) {
        const int b = chain / 12, h = (chain % 12) >> 1, dir = chain & 1;
        const unsigned char* chain_base = p.ws + WS_CH + (size_t)chain * 36 * CH_TASK_BYTES;
        f32x4 S[4];
#pragma unroll
        for (int t = 0; t < 4; ++t) S[t] = (f32x4){0.f, 0.f, 0.f, 0.f};
        const float glv = GL[chain * 36 + (lane < 36 ? lane : 35)];
        u32x4 pre[8]; uint2 upre[4];
#pragma unroll
        for (int i = 0; i < 8; ++i) pre[i] = *(const u32x4*)(chain_base + (size_t)(tid + 256 * i) * 16);
#pragma unroll
        for (int t = 0; t < 4; ++t) upre[t] = *(const uint2*)(chain_base + 4 * 8192 + ((wave * 16 + r16) * 64 + t * 16 + g4 * 4) * 2);
        bf16_t* Os = (bf16_t*)(smem + 36864);
#define SCAN_FLUSH(npf) do { int row0f, s0f, Lf, sbf; gdn_chunk_rows(b, dir, (npf), row0f, s0f, Lf, sbf); \
            _Pragma("unroll") for (int i = 0; i < 2; ++i) { const int c = (tid >> 3) + 32 * i, ti = dir ? 63 - c : c; \
                *(u32x4*)(GO + ((size_t)dir * NTOK + row0f + ti) * 384 + h * 64 + (tid & 7) * 8) = *(const u32x4*)(Os + c * 72 + (tid & 7) * 8); } } while (0)
        for (int np = 0; np < 36; ++np) {
            __syncthreads();
            if (np > 0) SCAN_FLUSH(np - 1);
#pragma unroll
            for (int i = 0; i < 8; ++i) {
                const int c = tid + 256 * i, mat = c >> 9, cc = c & 511, row = cc >> 3, kc = cc & 7;
                *(u32x4*)(smem + mat * 9216 + row * 144 + kc * 16) = pre[i];
            }
            uint2 ucur[4];
#pragma unroll
            for (int t = 0; t < 4; ++t) ucur[t] = upre[t];
            __syncthreads();
            {
                const int nn = (np + 1 < 36) ? np + 1 : np;
                const unsigned char* nb = chain_base + (size_t)nn * CH_TASK_BYTES;
#pragma unroll
                for (int i = 0; i < 8; ++i) pre[i] = *(const u32x4*)(nb + (size_t)(tid + 256 * i) * 16);
#pragma unroll
                for (int t = 0; t < 4; ++t) upre[t] = *(const uint2*)(nb + 4 * 8192 + ((wave * 16 + r16) * 64 + t * 16 + g4 * 4) * 2);
            }
            const float gl = readlane_f(glv, np);
            bf16x8 sb[2];
#pragma unroll
            for (int kk = 0; kk < 2; ++kk) {
                u32x4 pk;
                pk.x = cvt_pk_bf16(S[2 * kk][0], S[2 * kk][1]); pk.y = cvt_pk_bf16(S[2 * kk][2], S[2 * kk][3]);
                pk.z = cvt_pk_bf16(S[2 * kk + 1][0], S[2 * kk + 1][1]); pk.w = cvt_pk_bf16(S[2 * kk + 1][2], S[2 * kk + 1][3]);
                sb[kk] = __builtin_bit_cast(bf16x8, pk);
            }
            bf16x8 aw[4][2], aq[4][2], aa[4][2], ak[4][2];
#pragma unroll
            for (int t = 0; t < 4; ++t)
#pragma unroll
                for (int kk = 0; kk < 2; ++kk) aw[t][kk] = *(const bf16x8*)(smem + 0 * 9216 + (t * 16 + r16) * 144 + kk * 64 + g4 * 16);
#pragma unroll
            for (int t = 0; t < 4; ++t)
#pragma unroll
                for (int kk = 0; kk < 2; ++kk) aq[t][kk] = *(const bf16x8*)(smem + 1 * 9216 + (t * 16 + r16) * 144 + kk * 64 + g4 * 16);
            __builtin_amdgcn_sched_barrier(0);
            f32x4 VN[4];
#pragma unroll
            for (int t = 0; t < 4; ++t) VN[t] = (f32x4){lo_f(ucur[t].x), hi_f(ucur[t].x), lo_f(ucur[t].y), hi_f(ucur[t].y)};
#pragma unroll
            for (int kk = 0; kk < 2; ++kk)
#pragma unroll
                for (int t = 0; t < 4; ++t) VN[t] = __builtin_amdgcn_mfma_f32_16x16x32_bf16(aw[t][kk], sb[kk], VN[t], 0, 0, 0);
            __builtin_amdgcn_sched_barrier(0);
#pragma unroll
            for (int t = 0; t < 4; ++t)
#pragma unroll
                for (int kk = 0; kk < 2; ++kk) ak[t][kk] = *(const bf16x8*)(smem + 3 * 9216 + (t * 16 + r16) * 144 + kk * 64 + g4 * 16);
            f32x4 O[4];
#pragma unroll
            for (int t = 0; t < 4; ++t) O[t] = (f32x4){0.f, 0.f, 0.f, 0.f};
#pragma unroll
            for (int kk = 0; kk < 2; ++kk)
#pragma unroll
                for (int t = 0; t < 4; ++t) O[t] = __builtin_amdgcn_mfma_f32_16x16x32_bf16(aq[t][kk], sb[kk], O[t], 0, 0, 0);
            __builtin_amdgcn_sched_barrier(0);
#pragma unroll
            for (int t = 0; t < 4; ++t)
#pragma unroll
                for (int kk = 0; kk < 2; ++kk) aa[t][kk] = *(const bf16x8*)(smem + 2 * 9216 + (t * 16 + r16) * 144 + kk * 64 + g4 * 16);
            bf16x8 vb[2];
#pragma unroll
            for (int kk = 0; kk < 2; ++kk) {
                u32x4 pk;
                pk.x = cvt_pk_bf16(VN[2 * kk][0], VN[2 * kk][1]); pk.y = cvt_pk_bf16(VN[2 * kk][2], VN[2 * kk][3]);
                pk.z = cvt_pk_bf16(VN[2 * kk + 1][0], VN[2 * kk + 1][1]); pk.w = cvt_pk_bf16(VN[2 * kk + 1][2], VN[2 * kk + 1][3]);
                vb[kk] = __builtin_bit_cast(bf16x8, pk);
            }
            f32x4 sn[4];
#pragma unroll
            for (int t = 0; t < 4; ++t) sn[t] = S[t] * gl;
#pragma unroll
            for (int kk = 0; kk < 2; ++kk)
#pragma unroll
                for (int t = 0; t < 4; ++t) sn[t] = __builtin_amdgcn_mfma_f32_16x16x32_bf16(ak[t][kk], vb[kk], sn[t], 0, 0, 0);
#pragma unroll
            for (int kk = 0; kk < 2; ++kk)
#pragma unroll
                for (int t = 0; t < 4; ++t) O[t] = __builtin_amdgcn_mfma_f32_16x16x32_bf16(aa[t][kk], vb[kk], O[t], 0, 0, 0);
#pragma unroll
            for (int t = 0; t < 4; ++t) S[t] = sn[t];
            __builtin_amdgcn_sched_barrier(0);
#pragma unroll
            for (int t = 0; t < 4; ++t)
#pragma unroll
                for (int r = 0; r < 4; ++r) Os[(t * 16 + g4 * 4 + r) * 72 + wave * 16 + r16] = f2bf(O[t][r]);
        }
        __syncthreads();
        SCAN_FLUSH(35);
#undef SCAN_FLUSH
    }
}

DEVI void phase_gdn_scan(const Params& p, int l, unsigned char* smem) {
    phase_gdn_scan_chains(p, smem);
    const bool need_ctx = (l == 0);
    const int n_pool = (need_ctx ? NTOK : NX) / 16, n_att = NB * 16 * 6 + (need_ctx ? NB * 2 * 6 : 0);
    const int total = n_pool + n_att;
    unsigned* qhead = (unsigned*)(p.ws + WS_BAR) + 3600 + l;
    volatile unsigned* slot = (volatile unsigned*)(smem + SMEM_BYTES + 8);
    for (;;) {
        __syncthreads();
        if (threadIdx.x == 0) *slot = __hip_atomic_fetch_add(qhead, 1u, __ATOMIC_RELAXED, __HIP_MEMORY_SCOPE_AGENT);
        __syncthreads();
        const int q = (int)*slot;
        if (q >= total) break;
        const int u = (q < n_att) ? (n_pool + q) : (q - n_att);
        mix_task(p, l, u, n_pool, smem);
    }
}

DEVI void phase_gdn_finish(const Params& p, int l, int nrows) {
    const int lane = tidx() & 63, wave = tidx() >> 6;
    const bf16_t* GO = (const bf16_t*)(p.ws + WS_GO);
    const bf16_t* P = (const bf16_t*)(p.ws + WS_P);
    bf16_t* Y = (bf16_t*)(p.ws + WS_Y);
    const float4 gn = *(const float4*)(sp_ptr(p, SP_GDNN) + l * 64 + (lane & 15) * 4);
    for (int r = blockIdx.x * 4 + wave; r < nrows; r += gridDim.x * 4) {
#pragma unroll
        for (int ps = 0; ps < 2; ++ps) {
            const int ch = ps * 256 + lane * 4;
            if (ch < 384) {
                const uint2 a = *(const uint2*)(GO + (size_t)r * 384 + ch), b = *(const uint2*)(GO + ((size_t)NTOK + r) * 384 + ch);
                const uint2 zz = *(const uint2*)(P + (size_t)r * INW + C_GZ + ch);
                const float o0 = lo_f(a.x) + lo_f(b.x), o1 = hi_f(a.x) + hi_f(b.x), o2 = lo_f(a.y) + lo_f(b.y), o3 = hi_f(a.y) + hi_f(b.y);
                float ss = o0 * o0 + o1 * o1 + o2 * o2 + o3 * o3;
                ss += xor_lane<1>(ss); ss += xor_lane<2>(ss); ss += xor_lane<4>(ss); ss += xor_lane<8>(ss);
                const float rs = rsqrtf(ss * (1.f / 64.f) + 1e-6f);
                uint2 y;
                y.x = cvt_pk_bf16(o0 * rs * gn.x * silu_f(lo_f(zz.x)), o1 * rs * gn.y * silu_f(hi_f(zz.x)));
                y.y = cvt_pk_bf16(o2 * rs * gn.z * silu_f(lo_f(zz.y)), o3 * rs * gn.w * silu_f(hi_f(zz.y)));
                *(uint2*)(Y + (size_t)r * D + 256 + ch) = y;
            }
        }
    }
}

DEVI void cmpx(float& a, float& b) { const float t = fmaxf(a, b); b = fminf(a, b); a = t; }
template <int N> DEVI void bitonic_sort_desc(float (&v)[N]) {
#pragma unroll
    for (int k = 2; k <= N; k <<= 1) {
#pragma unroll
        for (int j = k >> 1; j > 0; j >>= 1) {
#pragma unroll
            for (int i = 0; i < N; ++i) {
                const int l = i ^ j;
                if (l > i) { if ((i & k) == 0) cmpx(v[i], v[l]); else cmpx(v[l], v[i]); }
            }
        }
    }
}
template <int N> DEVI void bitonic_merge_desc(float (&v)[N]) {
#pragma unroll
    for (int j = N >> 1; j > 0; j >>= 1) {
#pragma unroll
        for (int i = 0; i < N; ++i) { const int l = i ^ j; if (l > i) cmpx(v[i], v[l]); }
    }
}
DEVI void sort16_desc(float (&v)[16]) {
#define CX(i, j) cmpx(v[i], v[j])
    CX(0,13); CX(1,12); CX(2,15); CX(3,14); CX(4,8); CX(5,6); CX(7,11); CX(9,10);
    CX(0,5); CX(1,7); CX(2,9); CX(3,4); CX(6,13); CX(8,14); CX(10,15); CX(11,12);
    CX(0,1); CX(2,3); CX(4,5); CX(6,8); CX(7,9); CX(10,11); CX(12,13); CX(14,15);
    CX(0,2); CX(1,3); CX(4,10); CX(5,11); CX(6,7); CX(8,9); CX(12,14); CX(13,15);
    CX(1,2); CX(3,12); CX(4,6); CX(5,7); CX(8,10); CX(9,11); CX(13,14); CX(1,4);
    CX(2,6); CX(5,8); CX(7,10); CX(9,13); CX(11,14); CX(2,4); CX(3,6); CX(9,12);
    CX(11,13); CX(3,5); CX(6,8); CX(7,9); CX(10,12); CX(3,4); CX(5,6); CX(7,8);
    CX(9,10); CX(11,12); CX(6,7); CX(8,9);
#undef CX
}
DEVI void merge_top16(float (&a)[16], const float (&b)[16]) {
#pragma unroll
    for (int i = 0; i < 16; ++i) a[i] = fmaxf(a[i], b[15 - i]);
    bitonic_merge_desc<16>(a);
}
DEVI float pack_low(float v, unsigned mask, unsigned code) { return __uint_as_float((__float_as_uint(v) & ~mask) | code); }
DEVI void pk_stage2(const float (&A)[16], const float (&B)[16], float (&T)[16]) {
    float a[16], b[16];
#pragma unroll
    for (int i = 0; i < 16; ++i) { a[i] = pack_low(A[i], 127u, 0u); b[i] = pack_low(B[i], 127u, 0u); }
#define CAND(i, j) pack_low(a[i] + b[j], 255u, (unsigned)((i) * 16 + (j)))
#pragma unroll
    for (int j = 0; j < 16; ++j) T[j] = CAND(0, j);
    float G[16];
#pragma unroll
    for (int j = 0; j < 8; ++j) { G[j] = CAND(1, j); G[15 - j] = CAND(8 + j, 0); }
    bitonic_merge_desc<16>(G);
    merge_top16(T, G);
    G[0] = CAND(2, 0); G[1] = CAND(2, 1); G[2] = CAND(2, 2); G[3] = CAND(2, 3); G[4] = CAND(2, 4);
    G[5] = CAND(3, 0); G[6] = CAND(3, 1); G[7] = CAND(3, 2); G[8] = CAND(3, 3);
    G[9] = CAND(4, 0); G[10] = CAND(4, 1); G[11] = CAND(4, 2);
    G[12] = CAND(5, 0); G[13] = CAND(5, 1); G[14] = CAND(6, 0); G[15] = CAND(6, 1);
    sort16_desc(G);
    merge_top16(T, G);
    G[0] = CAND(7, 0); G[1] = CAND(7, 1);
#pragma unroll
    for (int i = 2; i < 16; ++i) G[i] = -3.0e38f;
    merge_top16(T, G);
#undef CAND
}

DEVI void qgemm_topk_epilogue(const Params& p, int l, int m0, int n0, const f32x4 (&acc)[4][4], unsigned char* smem) {
    const int tid = tidx(), lane = tid & 63, wave = __builtin_amdgcn_readfirstlane(tid >> 6);
    const int wm = wave >> 1, wn = wave & 1, r16 = lane & 15, q4 = lane >> 4, g4 = q4;
    constexpr int CS = 136;
    bf16_t* Cs = (bf16_t*)smem;
    float* rsv = (float*)(smem + 34816);
    unsigned char* klds = smem + 36864;
    const float* SSP = (const float*)(p.ws + WS_SSP);
    const float* BQ = (const float*)(p.ws + WS_BQ) + (size_t)l * 9 * 2048;
    const int hh = n0 >> 8, p2 = (n0 >> 7) & 1;
    const unsigned char* ksrc = (const unsigned char*)((const bf16_t*)(p.ws + WS_KB) + (((size_t)l * 8 + hh) * 2 + p2) * 128 * 128);
    u32x4 kreg[8];
#pragma unroll
    for (int it = 0; it < 8; ++it) kreg[it] = *(const u32x4*)(ksrc + (size_t)(tid + 256 * it) * 16);
    if (tid < 128) {
        const f32x4* sp4 = (const f32x4*)(SSP + (size_t)(m0 + tid) * 8);
        const f32x4 a = sp4[0], b = sp4[1];
        const float ss = ((a.x + a.y) + (a.z + a.w)) + ((b.x + b.y) + (b.z + b.w));
        rsv[tid] = rsqrtf(ss * (1.f / 1024.f) + 1e-6f);
    }
    __syncthreads();
    {
        const float* bq = BQ + (size_t)row_modrow(m0) * 2048 + n0 + wn * 64 + q4 * 4;
        float4 b4[4];
#pragma unroll
        for (int j = 0; j < 4; ++j) b4[j] = *(const float4*)(bq + j * 16);
#pragma unroll
        for (int i = 0; i < 4; ++i) {
            const int lrow = wm * 64 + i * 16 + r16;
            const float rs = rsv[lrow];
#pragma unroll
            for (int j = 0; j < 4; ++j) {
                uint2 pk;
                pk.x = cvt_pk_bf16(rs * acc[i][j][0] + b4[j].x, rs * acc[i][j][1] + b4[j].y);
                pk.y = cvt_pk_bf16(rs * acc[i][j][2] + b4[j].z, rs * acc[i][j][3] + b4[j].w);
                *(uint2*)(Cs + lrow * CS + wn * 64 + j * 16 + q4 * 4) = pk;
            }
        }
    }
#pragma unroll
    for (int it = 0; it < 8; ++it) {
        const int ci = tid + 256 * it, row = ci >> 4, c = ci & 15;
        *(u32x4*)(klds + (row * 16 + (c ^ (row & 15))) * 16) = kreg[it];
    }
    __syncthreads();
    float* LIST = (float*)(p.ws + WS_P);
#pragma unroll 1
    for (int pass = 0; pass < 2; ++pass) {
        const int lrow0 = wave * 32 + pass * 16;
        bf16x8 qf[4];
#pragma unroll
        for (int ks = 0; ks < 4; ++ks) qf[ks] = *(const bf16x8*)(Cs + (lrow0 + r16) * CS + ks * 32 + g4 * 8);
        float va[16], vb[16];
#pragma unroll
        for (int kt = 0; kt < 8; ++kt) {
            f32x4 sc = (f32x4){0.f, 0.f, 0.f, 0.f};
#pragma unroll
            for (int ks = 0; ks < 4; ++ks) {
                const bf16x8 a = *(const bf16x8*)(klds + ((kt * 16 + r16) * 16 + ((ks * 4 + g4) ^ r16)) * 16);
                sc = __builtin_amdgcn_mfma_f32_16x16x32_bf16(a, qf[ks], sc, 0, 0, 0);
            }
#pragma unroll
            for (int r = 0; r < 4; ++r) {
                const float pv = pack_low(sc[r], 127u, (unsigned)(127 - (16 * kt + r) - 4 * g4));
                if (kt < 4) va[kt * 4 + r] = pv; else vb[(kt - 4) * 4 + r] = pv;
            }
        }
        sort16_desc(va); sort16_desc(vb);
        merge_top16(va, vb);
#pragma unroll
        for (int i = 0; i < 16; ++i) vb[i] = xor_lane<16>(va[i]);
        merge_top16(va, vb);
#pragma unroll
        for (int i = 0; i < 16; ++i) vb[i] = xor_lane<32>(va[i]);
        merge_top16(va, vb);
        float4 o;
        o.x = (g4 == 0) ? va[0] : ((g4 == 1) ? va[4] : ((g4 == 2) ? va[8] : va[12]));
        o.y = (g4 == 0) ? va[1] : ((g4 == 1) ? va[5] : ((g4 == 2) ? va[9] : va[13]));
        o.z = (g4 == 0) ? va[2] : ((g4 == 1) ? va[6] : ((g4 == 2) ? va[10] : va[14]));
        o.w = (g4 == 0) ? va[3] : ((g4 == 1) ? va[7] : ((g4 == 2) ? va[11] : va[15]));
        *(float4*)(LIST + (size_t)(m0 + lrow0 + r16) * 256 + (hh * 2 + p2) * 16 + g4 * 4) = o;
    }
}
DEVI void topk2_item(const float* LIST, int row, int h, float* mylist, int (&ex)[16], float (&gt)[16]) {
    float A[16], B[16];
    {
        const float4* lp = (const float4*)(LIST + (size_t)row * 256 + h * 32);
#pragma unroll
        for (int q = 0; q < 4; ++q) {
            const float4 va = lp[q], vb = lp[4 + q];
            A[4 * q] = va.x; A[4 * q + 1] = va.y; A[4 * q + 2] = va.z; A[4 * q + 3] = va.w;
            B[4 * q] = vb.x; B[4 * q + 1] = vb.y; B[4 * q + 2] = vb.z; B[4 * q + 3] = vb.w;
        }
    }
#pragma unroll
    for (int i = 0; i < 16; ++i) { mylist[i] = A[i]; mylist[16 + i] = B[i]; }
    float T[16];
    pk_stage2(A, B, T);
    float m = -3.0e38f;
#pragma unroll
    for (int i = 0; i < 16; ++i) {
        const unsigned code = __float_as_uint(T[i]) & 255u;
        const float a = mylist[code >> 4], bq = mylist[16 + (code & 15u)];
        const unsigned ua = __float_as_uint(a), ub = __float_as_uint(bq);
        ex[i] = (int)((127u - (ua & 127u)) * 128u + (127u - (ub & 127u)));
        gt[i] = __uint_as_float(ua & ~127u) + __uint_as_float(ub & ~127u);
        m = fmaxf(m, gt[i]);
    }
    float s = 0.f;
#pragma unroll
    for (int i = 0; i < 16; ++i) { gt[i] = __expf(gt[i] - m); s += gt[i]; }
    const float inv = 1.f / s;
#pragma unroll
    for (int i = 0; i < 16; ++i) gt[i] *= inv;
}
DEVI void phase_topk(const Params& p, int l, int nrows, unsigned char* smem) {
    const int tid = tidx(), lane = tid & 63, wave = tid >> 6, r16 = lane & 15, g4 = lane >> 4;
    const bf16_t* Q = (const bf16_t*)(p.ws + WS_P);
    int* RIDX = (int*)(p.ws + WS_RIDX);
    float* RGATE = (float*)(p.ws + WS_RGATE);
    unsigned char* klds = smem;
    float* lists = (float*)(smem + 65536) + wave * (16 * 33);
    const int rows_per_chunk = nrows / 64, npass = rows_per_chunk / 16;
    for (int task = blockIdx.x; task < 512; task += gridDim.x) {
        const int h = task & 7, chunk = task >> 3;
        __syncthreads();
        {
            const unsigned char* ksrc = (const unsigned char*)((const bf16_t*)(p.ws + WS_KB) + ((size_t)l * 8 + h) * 2 * 128 * 128);
#pragma unroll 4
            for (int it = 0; it < 16; ++it) {
                const int ci = tid + 256 * it, row = ci >> 4, c = ci & 15;
                *(u32x4*)(klds + (row * 16 + (c ^ (row & 15))) * 16) = *(const u32x4*)(ksrc + (size_t)ci * 16);
            }
        }
        __syncthreads();
        for (int pass = wave; pass < npass; pass += 4) {
            const int row0 = chunk * rows_per_chunk + pass * 16;
            float AB[2][16];
#pragma unroll
            for (int p2 = 0; p2 < 2; ++p2) {
                bf16x8 qf[4];
#pragma unroll
                for (int ks = 0; ks < 4; ++ks) qf[ks] = *(const bf16x8*)(Q + (size_t)(row0 + r16) * 2048 + h * 256 + p2 * 128 + ks * 32 + g4 * 8);
                float va[16], vb[16];
#pragma unroll
                for (int kt = 0; kt < 8; ++kt) {
                    f32x4 acc = (f32x4){0.f, 0.f, 0.f, 0.f};
#pragma unroll
                    for (int ks = 0; ks < 4; ++ks) {
                        const bf16x8 a = *(const bf16x8*)(klds + ((p2 * 128 + kt * 16 + r16) * 16 + ((ks * 4 + g4) ^ r16)) * 16);
                        acc = __builtin_amdgcn_mfma_f32_16x16x32_bf16(a, qf[ks], acc, 0, 0, 0);
                    }
#pragma unroll
                    for (int r = 0; r < 4; ++r) {
                        const float pv = pack_low(acc[r], 127u, (unsigned)(127 - (16 * kt + r) - 4 * g4));
                        if (kt < 4) va[kt * 4 + r] = pv; else vb[(kt - 4) * 4 + r] = pv;
                    }
                }
                bitonic_sort_desc<16>(va); bitonic_sort_desc<16>(vb);
                merge_top16(va, vb);
#pragma unroll
                for (int i = 0; i < 16; ++i) vb[i] = xor_lane<16>(va[i]);
                merge_top16(va, vb);
#pragma unroll
                for (int i = 0; i < 16; ++i) vb[i] = xor_lane<32>(va[i]);
                merge_top16(va, vb);
#pragma unroll
                for (int i = 0; i < 16; ++i) AB[p2][i] = va[i];
            }
            if (g4 == 0) {
#pragma unroll
                for (int i = 0; i < 16; ++i) { lists[r16 * 33 + i] = AB[0][i]; lists[r16 * 33 + 16 + i] = AB[1][i]; }
            }
            __builtin_amdgcn_wave_barrier();
            float T[16];
            pk_stage2(AB[0], AB[1], T);
            float cv[4]; int ex[4];
#pragma unroll
            for (int r = 0; r < 4; ++r) {
                const float f = (g4 == 0) ? T[r] : ((g4 == 1) ? T[4 + r] : ((g4 == 2) ? T[8 + r] : T[12 + r]));
                const unsigned code = __float_as_uint(f) & 255u;
                const float a = lists[r16 * 33 + (code >> 4)], bq = lists[r16 * 33 + 16 + (code & 15u)];
                const unsigned ua = __float_as_uint(a), ub = __float_as_uint(bq);
                ex[r] = (int)((127u - (ua & 127u)) * 128u + (127u - (ub & 127u)));
                cv[r] = __uint_as_float(ua & ~127u) + __uint_as_float(ub & ~127u);
            }
            float m = fmaxf(fmaxf(cv[0], cv[1]), fmaxf(cv[2], cv[3]));
            m = fmaxf(m, xor_lane<16>(m)); m = fmaxf(m, xor_lane<32>(m));
            float e[4], s = 0.f;
#pragma unroll
            for (int r = 0; r < 4; ++r) { e[r] = __expf(cv[r] - m); s += e[r]; }
            s += xor_lane<16>(s); s += xor_lane<32>(s);
            const float inv = 1.f / s;
            const size_t o = (size_t)(row0 + r16) * 128 + h * 16 + g4 * 4;
            *(int4*)(RIDX + o) = make_int4(ex[0], ex[1], ex[2], ex[3]);
            *(float4*)(RGATE + o) = make_float4(e[0] * inv, e[1] * inv, e[2] * inv, e[3] * inv);
            __builtin_amdgcn_wave_barrier();
        }
    }
}

DEVI void peer_row_epilogue(const Params& p, int l, int r, int lane, const float (&acc)[16]) {
    bf16_t* H = (bf16_t*)(p.ws + WS_H);
    float* xr = xrow_ptr(p, r);
    const int mr = row_modrow(r);
    const float* g2 = mod_ptr(p, l, mr, 5);
    float xn[16]; float ss = 0.f;
#pragma unroll
    for (int q = 0; q < 4; ++q) {
        const int c = lane * 16 + q * 4;
        const float4 x0 = *(const float4*)(xr + c), ga = *(const float4*)(g2 + c);
        xn[q * 4 + 0] = x0.x + ga.x * acc[q * 4 + 0]; xn[q * 4 + 1] = x0.y + ga.y * acc[q * 4 + 1];
        xn[q * 4 + 2] = x0.z + ga.z * acc[q * 4 + 2]; xn[q * 4 + 3] = x0.w + ga.w * acc[q * 4 + 3];
        ss += xn[q * 4 + 0] * xn[q * 4 + 0] + xn[q * 4 + 1] * xn[q * 4 + 1] + xn[q * 4 + 2] * xn[q * 4 + 2] + xn[q * 4 + 3] * xn[q * 4 + 3];
    }
    ss = wave_sum(ss);
    const float rs = rsqrtf(ss * (1.f / 1024.f) + 1e-6f);
    if (l == 0) {
        const float* gain = sp_ptr(p, SP_NORM1 + D);
        const float* sh = mod_ptr(p, 1, mr, 0);
        const float* sc = mod_ptr(p, 1, mr, 1);
#pragma unroll
        for (int q = 0; q < 4; ++q) {
            const int c = lane * 16 + q * 4;
            *(float4*)(xr + c) = make_float4(xn[q * 4 + 0], xn[q * 4 + 1], xn[q * 4 + 2], xn[q * 4 + 3]);
            const float4 g = *(const float4*)(gain + c), a = *(const float4*)(sc + c), bb = *(const float4*)(sh + c);
            uint2 o;
            o.x = cvt_pk_bf16(xn[q * 4 + 0] * rs * g.x * (1.f + a.x) + bb.x, xn[q * 4 + 1] * rs * g.y * (1.f + a.y) + bb.y);
            o.y = cvt_pk_bf16(xn[q * 4 + 2] * rs * g.z * (1.f + a.z) + bb.z, xn[q * 4 + 3] * rs * g.w * (1.f + a.w) + bb.w);
            *(uint2*)(H + (size_t)r * D + c) = o;
        }
    } else {
        const float* gain = sp_ptr(p, SP_NORMF);
#pragma unroll
        for (int q = 0; q < 4; ++q) {
            const int c = lane * 16 + q * 4;
            const float4 g = *(const float4*)(gain + c);
            *(float4*)(xr + c) = make_float4(xn[q * 4 + 0] * rs * g.x, xn[q * 4 + 1] * rs * g.y, xn[q * 4 + 2] * rs * g.z, xn[q * 4 + 3] * rs * g.w);
        }
    }
}

struct PeerRowBatch { u32x3 uu[8]; int ev; float gate; };
DEVI void peer_rows_issue(PeerRowBatch& B, int t, int lane, int idx0, int idx1, float gt0, float gt1, const unsigned char* U8, const unsigned char* V8) {
    const int idxr = (t < 8) ? idx0 : idx1;
    const float gtr = (t < 8) ? gt0 : gt1;
    B.gate = __shfl(gtr, (t & 7) * 8 + (lane & 7));
    B.ev = __shfl(idxr, (t & 7) * 8 + (lane & 7));
#pragma unroll
    for (int j = 0; j < 8; ++j) {
        const int e = __builtin_amdgcn_readlane(idxr, (t & 7) * 8 + j);
        B.uu[j] = *(const u32x3*)(U8 + (size_t)e * 1536 + lane * 12);
    }
}
DEVI void peer_rows_compute(const PeerRowBatch& B, int lane, const f32x2 (&hv)[8], f32x2 (&acc)[8], const unsigned char* V8) {
    u32x3 vv[8];
#pragma unroll
    for (int j = 0; j < 8; ++j) {
        const int e = __builtin_amdgcn_readlane(B.ev, j);
        vv[j] = *(const u32x3*)(V8 + (size_t)e * 1536 + lane * 12);
    }
    float s[8];
#pragma unroll
    for (int j = 0; j < 8; j += 2) {
        const u32x6 w6 = (u32x6){B.uu[j][0], B.uu[j][1], B.uu[j][2], B.uu[j + 1][0], B.uu[j + 1][1], B.uu[j + 1][2]};
        const f32x32 f = __builtin_amdgcn_cvt_scalef32_pk32_f32_fp6(w6, 1.0f);
        f32x2 a2 = (f32x2){0.f, 0.f}, b2 = (f32x2){0.f, 0.f};
#pragma unroll
        for (int q = 0; q < 8; ++q) {
            a2 = (f32x2){f[2 * q], f[2 * q + 1]} * hv[q] + a2;
            b2 = (f32x2){f[16 + 2 * q], f[16 + 2 * q + 1]} * hv[q] + b2;
        }
        s[j] = a2.x + a2.y; s[j + 1] = b2.x + b2.y;
    }
    float t4[4], t2[2], tot;
#pragma unroll
    for (int i = 0; i < 4; ++i) {
        const float mine = (lane & 1) ? s[2 * i + 1] : s[2 * i], other = (lane & 1) ? s[2 * i] : s[2 * i + 1];
        t4[i] = mine + xor_lane<1>(other);
    }
#pragma unroll
    for (int i = 0; i < 2; ++i) {
        const float mine = (lane & 2) ? t4[2 * i + 1] : t4[2 * i], other = (lane & 2) ? t4[2 * i] : t4[2 * i + 1];
        t2[i] = mine + xor_lane<2>(other);
    }
    {
        const float mine = (lane & 4) ? t2[1] : t2[0], other = (lane & 4) ? t2[0] : t2[1];
        tot = mine + xor_lane<4>(other);
    }
    tot += xor_lane<8>(tot); tot += xor_lane<16>(tot); tot += xor_lane<32>(tot);
    const float w = B.gate * gelu_f(tot * (1.f / 64.f)) * 0.5f;
#pragma unroll
    for (int j = 0; j < 8; j += 2) {
        const float wa = readlane_f(w, j), wb = readlane_f(w, j + 1);
        const f32x2 wa2 = (f32x2){wa, wa}, wb2 = (f32x2){wb, wb};
        const u32x6 w6 = (u32x6){vv[j][0], vv[j][1], vv[j][2], vv[j + 1][0], vv[j + 1][1], vv[j + 1][2]};
        const f32x32 f = __builtin_amdgcn_cvt_scalef32_pk32_f32_fp6(w6, 1.0f);
#pragma unroll
        for (int q = 0; q < 8; ++q) {
            acc[q] = wa2 * (f32x2){f[2 * q], f[2 * q + 1]} + acc[q];
            acc[q] = wb2 * (f32x2){f[16 + 2 * q], f[16 + 2 * q + 1]} + acc[q];
        }
    }
}
DEVI void phase_peer_rows(const Params& p, int l, int nrows, unsigned char* smem) {
    const int lane = tidx() & 63, wave = __builtin_amdgcn_readfirstlane(tidx() >> 6);
    const bf16_t* H = (const bf16_t*)(p.ws + WS_H);
    const unsigned char* U8 = p.ws + WS_UB + (size_t)l * NEXP * 1536;
    const unsigned char* V8 = U8 + 768;
    const float* LIST = (const float*)(p.ws + WS_P);
    int* tabi = (int*)smem + wave * (9 * 128);
    float* tabg = (float*)(smem + 18432) + wave * (9 * 128);
    float* mylist = (float*)(smem + 36864 + wave * 8448) + lane * 33;
    uint2* lst = (uint2*)(smem + 36864 + wave * 8448);
    const int rstride = gridDim.x * 4;
#pragma unroll 1
    for (int rbase = blockIdx.x * 4 + wave; rbase < nrows; rbase += 9 * rstride) {
    int nk = 0;
    for (int k = 0; k < 9; ++k) if (rbase + k * rstride < nrows) nk = k + 1;
    __builtin_amdgcn_wave_barrier();
#pragma unroll 1
    for (int j0 = 0; j0 < nk * 8; j0 += 64) {
        const int j = j0 + lane;
        if (j < nk * 8) {
            const int k = j >> 3, h = j & 7;
            int ex[16]; float gt[16];
            topk2_item(LIST, rbase + k * rstride, h, mylist, ex, gt);
#pragma unroll
            for (int q = 0; q < 4; ++q) {
                *(int4*)(tabi + k * 128 + h * 16 + 4 * q) = make_int4(ex[4 * q], ex[4 * q + 1], ex[4 * q + 2], ex[4 * q + 3]);
                *(float4*)(tabg + k * 128 + h * 16 + 4 * q) = make_float4(gt[4 * q], gt[4 * q + 1], gt[4 * q + 2], gt[4 * q + 3]);
            }
        }
    }
    __builtin_amdgcn_wave_barrier();
#pragma unroll 1
    for (int kr = 0; kr < nk; ++kr) {
        const int r = rbase + kr * rstride;
        const u32x4 pa = *(const u32x4*)(H + (size_t)r * D + lane * 16), pb = *(const u32x4*)(H + (size_t)r * D + lane * 16 + 8);
        f32x2 hv[8];
        {
            const u32x4 a = pa, b = pb;
            const f32x4* sp4 = (const f32x4*)((const float*)(p.ws + WS_SSP) + (size_t)r * 8);
            const f32x4 s0 = sp4[0], s1 = sp4[1];
            const float ss = ((s0.x + s0.y) + (s0.z + s0.w)) + ((s1.x + s1.y) + (s1.z + s1.w));
            const float rs = rsqrtf(ss * (1.f / 1024.f) + 1e-6f);
            const float4* sh4 = (const float4*)(mod_ptr(p, l, row_modrow(r), 3) + lane * 16);
            const float4 h0 = sh4[0], h1 = sh4[1], h2 = sh4[2], h3 = sh4[3];
            hv[0] = (f32x2){rs * lo_f(a.x) + h0.x, rs * hi_f(a.x) + h0.y}; hv[1] = (f32x2){rs * lo_f(a.y) + h0.z, rs * hi_f(a.y) + h0.w};
            hv[2] = (f32x2){rs * lo_f(a.z) + h1.x, rs * hi_f(a.z) + h1.y}; hv[3] = (f32x2){rs * lo_f(a.w) + h1.z, rs * hi_f(a.w) + h1.w};
            hv[4] = (f32x2){rs * lo_f(b.x) + h2.x, rs * hi_f(b.x) + h2.y}; hv[5] = (f32x2){rs * lo_f(b.y) + h2.z, rs * hi_f(b.y) + h2.w};
            hv[6] = (f32x2){rs * lo_f(b.z) + h3.x, rs * hi_f(b.z) + h3.y}; hv[7] = (f32x2){rs * lo_f(b.w) + h3.z, rs * hi_f(b.w) + h3.w};
        }
        int lo = lane;
        asm volatile("" : "+v"(lo));
        const int* ti = (const int*)smem + wave * (9 * 128) + kr * 128 + lo;
        const float* tg = (const float*)(smem + 18432) + wave * (9 * 128) + kr * 128 + lo;
        int idx0 = ti[0], idx1 = ti[64];
        float gt0 = tg[0], gt1 = tg[64];
        {
            const int bflip = (kr & 1) ? 15 : 0;
            const int b0 = (idx0 >> 10) ^ bflip, b1 = (idx1 >> 10) ^ bflip;
            int basec = 0, pos0 = 0, pos1 = 0;
#pragma unroll
            for (int bb = 0; bb < 16; ++bb) {
                const unsigned long long m0 = __ballot(b0 == bb), m1 = __ballot(b1 == bb);
                const int c0 = __popcll(m0);
                const int below0 = __builtin_amdgcn_mbcnt_hi((unsigned)(m0 >> 32), __builtin_amdgcn_mbcnt_lo((unsigned)m0, 0));
                const int below1 = __builtin_amdgcn_mbcnt_hi((unsigned)(m1 >> 32), __builtin_amdgcn_mbcnt_lo((unsigned)m1, 0));
                if (b0 == bb) pos0 = basec + below0;
                if (b1 == bb) pos1 = basec + c0 + below1;
                basec += c0 + __popcll(m1);
            }
            __builtin_amdgcn_wave_barrier();
            lst[pos0] = make_uint2((unsigned)idx0, __float_as_uint(gt0));
            lst[pos1] = make_uint2((unsigned)idx1, __float_as_uint(gt1));
            __builtin_amdgcn_wave_barrier();
            const uint2 e0 = lst[lane], e1 = lst[64 + lane];
            idx0 = (int)e0.x; gt0 = __uint_as_float(e0.y); idx1 = (int)e1.x; gt1 = __uint_as_float(e1.y);
            __builtin_amdgcn_wave_barrier();
        }
        f32x2 acc[8];
#pragma unroll
        for (int i = 0; i < 8; ++i) acc[i] = (f32x2){0.f, 0.f};
        PeerRowBatch A, Bq;
        peer_rows_issue(A, 0, lane, idx0, idx1, gt0, gt1, U8, V8);
#pragma unroll 1
        for (int t = 0; t < 16; t += 2) {
            peer_rows_issue(Bq, t + 1, lane, idx0, idx1, gt0, gt1, U8, V8);
            peer_rows_compute(A, lane, hv, acc, V8);
            peer_rows_issue(A, (t + 2 < 16) ? t + 2 : 15, lane, idx0, idx1, gt0, gt1, U8, V8);
            peer_rows_compute(Bq, lane, hv, acc, V8);
        }
        float ar[16];
#pragma unroll
        for (int i = 0; i < 8; ++i) { ar[2 * i] = acc[i].x; ar[2 * i + 1] = acc[i].y; }
        int le = lane;
        asm volatile("" : "+v"(le));
        peer_row_epilogue(p, l, r, le, ar);
    }
    }
}

DEVI void phase_peer(const Params& p, int l, int nrows, unsigned char* smem) {
    phase_peer_rows(p, l, nrows, smem);
}

constexpr int N_PHASES = 23;
template <int K>
DEVI void run_kind(const Params& pin, int lin, unsigned char* smem) {
    Params p = pin; int l = lin;
    {
        unsigned long long w = (unsigned long long)pin.ws, o = (unsigned long long)pin.out;
        asm volatile("" : "+s"(w), "+s"(o), "+s"(l));
        p.ws = (unsigned char*)(__attribute__((address_space(1))) unsigned char*)w;
        p.out = (float*)(__attribute__((address_space(1))) float*)o;
    }
    unsigned char* ws = p.ws;
    const int nrows_act = (l == 0) ? NTOK : NX;
    if (K == 10) phase_prep(p, smem);
    if (K == 11) phase_modred(p);
    if (K == 0) { phase_norm(p, l, 0, NTOK); phase_qbias(p); }
    if (K == 1) phase_gemm<0>(p, (const bf16_t*)(ws + WS_H), (const bf16_t*)(ws + WS_WINT) + (size_t)l * INWP * 1024, NTOK, INWP, INW, (bf16_t*)(ws + WS_P), INW, l, smem);
    if (K == 2) phase_mix1(p, l, smem);
    if (K == 3) phase_gdn_scan(p, l, smem);
    if (K == 4) phase_gdn_finish(p, l, nrows_act);
    if (K == 5) phase_gemm<1>(p, (const bf16_t*)(ws + WS_Y), (const bf16_t*)(ws + WS_WOUTT) + (size_t)l * 1024 * 1024, nrows_act, 1024, 1024, (bf16_t*)(ws + WS_H), 1024, l, smem);
    if (K == 7) phase_gemm<3>(p, (const bf16_t*)(ws + WS_H), (const bf16_t*)(ws + WS_WQT) + (size_t)l * 2048 * 1024, nrows_act, 2048, 2048, (bf16_t*)(ws + WS_P), 2048, l, smem);
    if (K == 8) { }
    if (K == 9) phase_peer(p, l, nrows_act, smem);
}

#ifndef PROBE_MASK
#define PROBE_MASK 0
#endif
#if N_LAUNCH_MODE == 0
template <int K>
__global__ void __launch_bounds__(NT, 2) phase_kernel(Params p, int l) {
    __shared__ __attribute__((aligned(1024))) unsigned char smem[SMEM_BYTES + 16];
    run_kind<K>(p, l, smem);
}
#else
__global__ void __launch_bounds__(NT, 2) mk_kernel(Params p) {
    __shared__ __attribute__((aligned(1024))) unsigned char smem[SMEM_BYTES + 16];
    if (threadIdx.x == 0) *(uint4*)(smem + SMEM_BYTES) = make_uint4(0u, 0u, 0u, 0u);
    __syncthreads();
    XcdBarrier bar = xcd_barrier_post((unsigned*)(p.ws + WS_BAR), (volatile LAS unsigned*)(smem + SMEM_BYTES));
    run_kind<10>(p, 0, smem); xcd_barrier_census(bar); xcd_barrier(bar);
    run_kind<11>(p, 0, smem); xcd_barrier(bar);
#define MK_LAYER(l) do { \
        if (l == 0) { run_kind<0>(p, l, smem); xcd_barrier(bar); } \
        run_kind<1>(p, l, smem); xcd_barrier(bar); if (PROBE_MASK & (1 << 1)) { run_kind<1>(p, l, smem); xcd_barrier(bar); } \
        run_kind<2>(p, l, smem); xcd_barrier(bar); if (PROBE_MASK & (1 << 2)) { run_kind<2>(p, l, smem); xcd_barrier(bar); } \
        run_kind<3>(p, l, smem); xcd_barrier(bar); if (PROBE_MASK & (1 << 3)) { run_kind<3>(p, l, smem); xcd_barrier(bar); } \
        run_kind<4>(p, l, smem); xcd_barrier(bar); if (PROBE_MASK & (1 << 4)) { run_kind<4>(p, l, smem); xcd_barrier(bar); } \
        run_kind<5>(p, l, smem); xcd_barrier(bar); if (PROBE_MASK & (1 << 5)) { run_kind<5>(p, l, smem); xcd_barrier(bar); } \
        run_kind<7>(p, l, smem); xcd_barrier(bar); if (PROBE_MASK & (1 << 7)) { run_kind<7>(p, l, smem); xcd_barrier(bar); } \
        run_kind<9>(p, l, smem); if (l == 0) xcd_barrier(bar); \
    } while (0)
    MK_LAYER(0);
    MK_LAYER(1);
#undef MK_LAYER
}
#endif

extern "C" void kernel_launch(void* const* d_in, const int* in_sizes, int n_in, void* d_out, int out_size, void* d_ws, size_t ws_size, hipStream_t stream) {
    if (n_in != 22 || ws_size < WS_TOTAL) { fprintf(stderr, "kernel_launch: unexpected n_in %d or ws_size %zu < %zu\n", n_in, ws_size, (size_t)WS_TOTAL); return; }
    Params p{};
    for (int i = 0; i < 22; ++i) p.in[i] = (const float*)d_in[i];
    p.out = (float*)d_out; p.ws = (unsigned char*)d_ws;
#if N_LAUNCH_MODE == 0
    const dim3 g(2048), b(NT);
    (void)hipMemsetAsync((unsigned char*)d_ws + WS_BAR, 0, 16384, stream);
    hipLaunchKernelGGL(phase_kernel<10>, g, b, 0, stream, p, 0);
    hipLaunchKernelGGL(phase_kernel<11>, g, b, 0, stream, p, 0);
    for (int l = 0; l < 2; ++l) {
        if (l == 0) hipLaunchKernelGGL(phase_kernel<0>, g, b, 0, stream, p, l);
        hipLaunchKernelGGL(phase_kernel<1>, g, b, 0, stream, p, l);
        hipLaunchKernelGGL(phase_kernel<2>, g, b, 0, stream, p, l);
        hipLaunchKernelGGL(phase_kernel<3>, dim3(24), b, 0, stream, p, l);
        hipLaunchKernelGGL(phase_kernel<4>, g, b, 0, stream, p, l);
        hipLaunchKernelGGL(phase_kernel<5>, g, b, 0, stream, p, l);
        hipLaunchKernelGGL(phase_kernel<7>, g, b, 0, stream, p, l);
        hipLaunchKernelGGL(phase_kernel<8>, g, b, 0, stream, p, l);
        hipLaunchKernelGGL(phase_kernel<9>, g, b, 0, stream, p, l);
    }
#else
    static int grid = 0;
    if (grid == 0) {
        int dev = 0, cus = 0, per_cu = 0;
        hipGetDevice(&dev);
        hipDeviceGetAttribute(&cus, hipDeviceAttributeMultiprocessorCount, dev);
        hipOccupancyMaxActiveBlocksPerMultiprocessor(&per_cu, (const void*)mk_kernel, NT, 0);
        if (per_cu > 2) per_cu = 2;
        if (per_cu < 1) per_cu = 1;
        grid = cus * per_cu;
    }
    hipMemsetAsync((unsigned char*)d_ws + WS_BAR, 0, 16384, stream);
    hipLaunchKernelGGL(mk_kernel, dim3(grid), dim3(NT), 0, stream, p);
#endif
}
```
